# Optimizing an MI355X kernel written in HIP

```python
import jax, jax.numpy as jnp
from jax import lax
import numpy as np

D_MODEL = 1024
BATCH = 8
SEQ = 4096
DEPTH = 2
DEC_BATCH = 2
DEC_SEQ = 16384
PAST_LEN = 128

MIX_WIDTH = D_MODEL
HG_HEADS = 4
HG_KEY = 128
HG_VAL = 128
HG_QK = HG_HEADS * HG_KEY
HG_V = HG_HEADS * HG_VAL
HG_CHUNK = 64
SG_HEADS = 4
SG_HEAD_DIM = (MIX_WIDTH - HG_V) // SG_HEADS
SG_WIDTH = SG_HEADS * SG_HEAD_DIM
SG_CHUNK = 128
IN_COLS = 3 * HG_QK + 2 * HG_V + 2 * SG_WIDTH
D_FF = 2816
CONV_W = 3
EPS = 1e-6

kernel_name = "hybrid_hgrn2_spatial_gating_encoder"


def _rmsnorm(x, g):
    xf = x.astype(jnp.float32)
    y = xf * lax.rsqrt(jnp.mean(xf * xf, axis=-1, keepdims=True) + EPS)
    return (y * g.astype(jnp.float32)).astype(x.dtype)


def _layernorm(x, g, b):
    xf = x.astype(jnp.float32)
    mu = jnp.mean(xf, axis=-1, keepdims=True)
    xc = xf - mu
    y = xc * lax.rsqrt(jnp.mean(xc * xc, axis=-1, keepdims=True) + EPS)
    return (y * g.astype(jnp.float32) + b.astype(jnp.float32)).astype(x.dtype)


def _hgrn2_direction(q, log_f, v):
    B, S, H, K = q.shape
    V = v.shape[-1]
    C = HG_CHUNK
    N = S // C
    k = -jnp.expm1(log_f)

    def to_chunks(a):
        return a.reshape(B, N, C, H, a.shape[-1]).transpose(1, 0, 3, 2, 4)

    qc, kc, vc = to_chunks(q), to_chunks(k), to_chunks(v)
    bc = jnp.cumsum(to_chunks(log_f), axis=3)
    lower = jnp.tril(jnp.ones((C, C), dtype=bool))[:, :, None]

    def step(state, inp):
        qq, kk, vv, bb = inp
        b_last = bb[:, :, -1:, :]
        o_inter = jnp.einsum('bhtk,bhkv->bhtv', qq * jnp.exp(bb), state)
        diff = bb[:, :, :, None, :] - bb[:, :, None, :, :]
        decay = jnp.where(lower, jnp.exp(jnp.minimum(diff, 0.0)), 0.0)
        scores = jnp.einsum('bhtk,bhsk,bhtsk->bhts', qq, kk, decay)
        o_intra = jnp.einsum('bhts,bhsv->bhtv', scores, vv)
        state = (jnp.exp(b_last[:, :, 0, :])[..., None] * state
                 + jnp.einsum('bhsk,bhsv->bhkv', kk * jnp.exp(b_last - bb), vv))
        return state, o_inter + o_intra

    s0 = jnp.zeros((B, H, K, V), jnp.float32)
    _, o = lax.scan(step, s0, (qc, kc, vc, bc))
    return o.transpose(1, 0, 3, 2, 4).reshape(B, S, H, V)


def _log_forget(z, lb):
    lb = lb.reshape(HG_HEADS, HG_KEY)
    return jnp.log(lb + (1.0 - lb) * jax.nn.sigmoid(z))


def _dwconv_centred(a, w, b):
    S = a.shape[1]
    ap = jnp.pad(a, ((0, 0), (1, 1), (0, 0)))
    return ap[:, :S] * w[0] + ap[:, 1:S + 1] * w[1] + ap[:, 2:] * w[2] + b


def _trunk(x, norm1_g, w_in, hg_lb_logits, hg_norm_g, sg_norm_g, sg_norm_b, sg_w_spatial,
           sg_b_spatial, w_out, norm2_g, w_ffn_in, ffn_conv_w, ffn_conv_b, w_ffn_out, final_norm_g):
    B, S, _ = x.shape
    dt = x.dtype
    p = jax.nn.softmax(hg_lb_logits.astype(jnp.float32), axis=1)
    lb_all = jnp.cumsum(p, axis=1) - p[:, :1]
    splits = np.cumsum([HG_QK, HG_QK, HG_QK, HG_V, HG_V, SG_WIDTH]).tolist()
    n_sg = S // SG_CHUNK
    for l in range(DEPTH):
        h = _rmsnorm(x, norm1_g[l])
        proj = h @ w_in[l]
        q, f_fw, f_bw, i_in, g, u, v = jnp.split(proj, splits, axis=-1)
        hk = lambda a: a.astype(jnp.float32).reshape(B, S, HG_HEADS, -1)
        qf, vf = hk(q), hk(i_in)
        lf_fw = _log_forget(hk(f_fw), lb_all[0, l])
        lf_bw = _log_forget(hk(f_bw), lb_all[1, l])
        o_fw = _hgrn2_direction(qf, lf_fw, vf)
        o_bw = jnp.flip(_hgrn2_direction(jnp.flip(qf, 1), jnp.flip(lf_bw, 1), jnp.flip(vf, 1)), 1)
        o = _rmsnorm(o_fw + o_bw, hg_norm_g[l].reshape(HG_HEADS, HG_VAL)).reshape(B, S, HG_V)
        hg_out = (o * jax.nn.silu(g.astype(jnp.float32))).astype(dt)
        u = jax.nn.gelu(u)
        vh = jax.nn.gelu(v).reshape(B, S, SG_HEADS, SG_HEAD_DIM)
        vh = _layernorm(vh, sg_norm_g[l].reshape(SG_HEADS, SG_HEAD_DIM), sg_norm_b[l].reshape(SG_HEADS, SG_HEAD_DIM))
        vc = vh.reshape(B, n_sg, SG_CHUNK, SG_HEADS, SG_HEAD_DIM)
        sp = jnp.einsum('hpq,bcqhd->bcphd', sg_w_spatial[l], vc) + sg_b_spatial[l].T[None, None, :, :, None]
        sg_out = u * sp.reshape(B, S, SG_WIDTH)
        x = x + (jnp.concatenate([hg_out, sg_out.astype(dt)], axis=-1) @ w_out[l]).astype(dt)
        h = _rmsnorm(x, norm2_g[l])
        a = _dwconv_centred(h @ w_ffn_in[l], ffn_conv_w[l], ffn_conv_b[l])
        gate, up = jnp.split(a, 2, axis=-1)
        x = x + ((jax.nn.silu(gate) * up) @ w_ffn_out[l]).astype(dt)
    return _rmsnorm(x, final_norm_g)


def setup_inputs(seed: int = 0) -> dict:
    key = jax.random.key(seed)
    ks = jax.random.split(key, 18)
    nrm = lambda k, shape, s: jax.random.normal(k, shape, jnp.float32) * s
    return {
        "x_prompt": nrm(ks[0], (BATCH, SEQ, D_MODEL), 1.0),
        "x_sample": nrm(ks[1], (DEC_BATCH, DEC_SEQ, D_MODEL), 1.0),
        "norm1_g": 1.0 + nrm(ks[2], (DEPTH, D_MODEL), 0.02),
        "w_in": nrm(ks[3], (DEPTH, D_MODEL, IN_COLS), D_MODEL ** -0.5),
        "hg_lb_logits": nrm(ks[4], (2, DEPTH, HG_QK), 1.0),
        "hg_norm_g": 1.0 + nrm(ks[5], (DEPTH, HG_V), 0.02),
        "sg_norm_g": 1.0 + nrm(ks[6], (DEPTH, SG_WIDTH), 0.02),
        "sg_norm_b": nrm(ks[7], (DEPTH, SG_WIDTH), 0.02),
        "sg_w_spatial": nrm(ks[8], (DEPTH, SG_HEADS, SG_CHUNK, SG_CHUNK), 0.5 * SG_CHUNK ** -0.5),
        "sg_b_spatial": 1.0 + nrm(ks[9], (DEPTH, SG_HEADS, SG_CHUNK), 0.1),
        "w_out": nrm(ks[10], (DEPTH, MIX_WIDTH, D_MODEL), MIX_WIDTH ** -0.5),
        "norm2_g": 1.0 + nrm(ks[11], (DEPTH, D_MODEL), 0.02),
        "w_ffn_in": nrm(ks[12], (DEPTH, D_MODEL, 2 * D_FF), D_MODEL ** -0.5),
        "ffn_conv_w": nrm(ks[13], (DEPTH, CONV_W, 2 * D_FF), CONV_W ** -0.5),
        "ffn_conv_b": nrm(ks[14], (DEPTH, 2 * D_FF), 0.02),
        "w_ffn_out": nrm(ks[15], (DEPTH, D_FF, D_MODEL), D_FF ** -0.5),
        "final_norm_g": 1.0 + nrm(ks[16], (D_MODEL,), 0.02),
    }


def reference(x_prompt, x_sample, norm1_g, w_in, hg_lb_logits, hg_norm_g, sg_norm_g, sg_norm_b,
              sg_w_spatial, sg_b_spatial, w_out, norm2_g, w_ffn_in, ffn_conv_w, ffn_conv_b,
              w_ffn_out, final_norm_g):
    y_prompt = _trunk(x_prompt, norm1_g, w_in, hg_lb_logits, hg_norm_g, sg_norm_g, sg_norm_b,
                      sg_w_spatial, sg_b_spatial, w_out, norm2_g, w_ffn_in, ffn_conv_w, ffn_conv_b,
                      w_ffn_out, final_norm_g)
    y_sample = _trunk(x_sample, norm1_g, w_in, hg_lb_logits, hg_norm_g, sg_norm_g, sg_norm_b,
                      sg_w_spatial, sg_b_spatial, w_out, norm2_g, w_ffn_in, ffn_conv_w, ffn_conv_b,
                      w_ffn_out, final_norm_g)
    return (y_prompt, y_sample)
```

```cpp
#include <hip/hip_runtime.h>
#include <hip/hip_cooperative_groups.h>
#include <cstdio>
namespace cg = cooperative_groups;
__device__ __forceinline__ int mk_tid() { int t = threadIdx.x; asm volatile("" : "+v"(t)); return t; }
__device__ __forceinline__ int mk_bid() { int t = blockIdx.x; asm volatile("" : "+s"(t)); return t; }
#define ONE_LAUNCH 1

namespace pg8 {
#define PG8_LAS __attribute__((address_space(3)))
typedef unsigned short bf16_t;
typedef short bf16x8 __attribute__((ext_vector_type(8)));
typedef float f32x4 __attribute__((ext_vector_type(4)));
typedef unsigned u32x4 __attribute__((ext_vector_type(4)));
constexpr int BM = 256, BK = 64, HALF = 128, HTB = HALF * BK * 2  , STAGE_BYTES = 8 * HTB, NXCD = 8, WGM = 8;

__host__ __device__ __forceinline__ int lds_byte(int r, int c) { const int st = (r >> 4) * 2 + (c >> 5), rr = r & 15, cc = c & 31, ob = rr * 64 + cc * 2; return st * 1024 + (ob ^ (((ob >> 9) & 1) << 5)); }
__host__ __device__ __forceinline__ void stage_rc(int b, int& R, int& C) { const int st = b / 1024, sb = b % 1024, swz = sb ^ (((sb >> 9) & 1) << 5); R = (st >> 1) * 16 + swz / 64; C = (st & 1) * 32 + (swz % 64) / 2; }
__host__ __device__ __forceinline__ int perm32(int rho) { const int n = rho >> 4, i = rho & 15; return 8 * (i >> 2) + 4 * n + (i & 3); }

struct Unit { int pm, pn; };
struct Gemm { const bf16_t* A; const bf16_t* Bt; int M, N, K; };

struct StaticOrder {
    int nM, nN, nwg, G, c;
    __host__ __device__ void init(int M, int N, int G_, int c_) { nM = M / BM; nN = N / BM; nwg = nM * nN; G = G_; c = c_; }
    __host__ __device__ bool next(int i, Unit& u) const {
        const long L = (long)i * G + c; if (L >= nwg) return false;
        int wgid = (int)L; { const int q = nwg / NXCD, r = nwg % NXCD, xcd = wgid % NXCD, off = wgid / NXCD; wgid = (xcd < r ? xcd * (q + 1) : r * (q + 1) + (xcd - r) * q) + off; }
        const int nig = WGM * nN, gid = wgid / nig, fm = gid * WGM, gsz = (nM - fm) < WGM ? (nM - fm) : WGM;
        u.pm = fm + ((wgid % nig) % gsz); u.pn = (wgid % nig) / gsz; return true;
    }
    __device__ __forceinline__ void a_ready(const Unit&) const {}
    __device__ __forceinline__ void done(const Unit&) const {}
};
__device__ __forceinline__ unsigned cvt_pk_bf16(float lo, float hi) { unsigned r; asm("v_cvt_pk_bf16_f32 %0, %1, %2" : "=v"(r) : "v"(lo), "v"(hi)); return r; }
template <class Epi, class Sched, bool STAMP = false>
__device__ __forceinline__ void gemm_phase(PG8_LAS unsigned char* lds, const Gemm g, const Sched& S, const Epi& E, unsigned long long* stamps) {
    const int tid = mk_tid(), wid = __builtin_amdgcn_readfirstlane(tid >> 6), lane = tid & 63, wr = wid >> 2, wc = wid & 3, fr = lane & 15, fq = lane >> 4;
    const int K = g.K, nt = K / BK;
    int ts_lo = 0, ts_hi = 0, nts = 0; const unsigned long long rt_entry = STAMP ? (unsigned long long)wall_clock64() : 0ull;
#define PG8_STAMP() do { if (STAMP && wid == 0 && nts < 64) { const unsigned long long _c = (unsigned long long)clock64(); \
        ts_lo = (lane == nts) ? (int)(unsigned)_c : ts_lo; ts_hi = (lane == nts) ? (int)(unsigned)(_c >> 32) : ts_hi; ++nts; } } while (0)
    PG8_STAMP();
    unsigned voffA[2], voffB[2];
#pragma unroll
    for (int i = 0; i < 2; ++i) { int R, C; stage_rc(tid * 16 + i * 8192, R, C); const int Rb = Epi::PERM ? ((R & ~31) + perm32(R & 31)) : R;
        voffA[i] = (unsigned)(R * K + C) * 2u; voffB[i] = (unsigned)(Rb * K + C) * 2u; }
    const size_t kstep = (size_t)(BK * 2);
    const size_t hstep = (size_t)HALF * K * 2;
    const size_t tstep = 2 * hstep;
    const unsigned ldsw = (unsigned)wid * 1024u;
    const int aoff = lds_byte(wr * 64 + fr, fq * 8), boff = lds_byte(wc * 32 + fr, fq * 8);
#define PG8_SA(b, h) (((b) * 2 + (h)) * HTB)
#define PG8_SB(b, h) ((4 + (b) * 2 + (h)) * HTB)
#define PG8_STAGE(bufoff, gbase, voff) do { _Pragma("unroll") for (int _i = 0; _i < 2; ++_i) \
        __builtin_amdgcn_global_load_lds((const unsigned*)((const char*)(gbase) + (voff)[_i]), (PG8_LAS unsigned*)(lds + (bufoff) + ldsw + _i * 8192), 16, 0, 0); } while (0)
#define PG8_LDA(dst, b, h) do { _Pragma("unroll") for (int m = 0; m < 4; ++m) _Pragma("unroll") for (int k = 0; k < 2; ++k) dst[m][k] = *(const PG8_LAS bf16x8*)(lds + PG8_SA(b, h) + aoff + m * 2048 + k * 1024); } while (0)
#define PG8_LDB(dst, b, h) do { _Pragma("unroll") for (int n = 0; n < 2; ++n) _Pragma("unroll") for (int k = 0; k < 2; ++k) dst[n][k] = *(const PG8_LAS bf16x8*)(lds + PG8_SB(b, h) + boff + n * 2048 + k * 1024); } while (0)
#define PG8_MMA(ai, bj, At, Bt) do { __builtin_amdgcn_s_setprio(1); _Pragma("unroll") for (int m = 0; m < 4; ++m) _Pragma("unroll") for (int n = 0; n < 2; ++n) _Pragma("unroll") for (int k = 0; k < 2; ++k) \
        acc[ai][bj][m][n] = __builtin_amdgcn_mfma_f32_16x16x32_bf16(Bt[n][k], At[m][k], acc[ai][bj][m][n], 0, 0, 0); __builtin_amdgcn_s_setprio(0); } while (0)
#define PG8_WAIT_V(n) asm volatile("s_waitcnt vmcnt(" #n ")" ::: "memory")
#define PG8_WAIT_L(n) asm volatile("s_waitcnt lgkmcnt(" #n ")" ::: "memory")
#define PG8_BAR __builtin_amdgcn_s_barrier()
#define PG8_SCHED __builtin_amdgcn_sched_barrier(0)
    Unit cur, nxt; int ui = 0;
    if (!S.next(0, cur)) return;
    f32x4 acc[2][2][4][2];
#pragma unroll
    for (int a = 0; a < 2; ++a)
#pragma unroll
        for (int b = 0; b < 2; ++b)
#pragma unroll
            for (int m = 0; m < 4; ++m)
#pragma unroll
                for (int n = 0; n < 2; ++n) acc[a][b][m][n] = (f32x4){0.f, 0.f, 0.f, 0.f};
    bf16x8 At[4][2], B0[2][2], B1[2][2];
    const char* cA = (const char*)g.A + (size_t)cur.pm * tstep; const char* cB = (const char*)g.Bt + (size_t)cur.pn * tstep;
    S.a_ready(cur);
    PG8_STAGE(PG8_SB(0, 0), cB, voffB); PG8_STAGE(PG8_SA(0, 0), cA, voffA); PG8_STAGE(PG8_SB(0, 1), cB + hstep, voffB); PG8_STAGE(PG8_SA(0, 1), cA + hstep, voffA);
    if (wr == 1) PG8_BAR;
    PG8_WAIT_V(4); PG8_BAR;
    PG8_STAGE(PG8_SB(1, 0), cB + kstep, voffB); PG8_STAGE(PG8_SA(1, 0), cA + kstep, voffA); PG8_STAGE(PG8_SB(1, 1), cB + hstep + kstep, voffB);
    PG8_WAIT_V(6); PG8_BAR;
    PG8_STAMP();
    for (;;) {
        const bool has_next = S.next(ui + 1, nxt);
        const char* nA = has_next ? (const char*)g.A + (size_t)nxt.pm * tstep : cA; const char* nB = has_next ? (const char*)g.Bt + (size_t)nxt.pn * tstep : cB;
        for (int t = 0; t < nt; t += 2) {
            const bool last = (t == nt - 2);
            const char* a1 = cA + (size_t)(t + 1) * kstep;
            const char* a2 = last ? nA : cA + (size_t)(t + 2) * kstep; const char* b2 = last ? nB : cB + (size_t)(t + 2) * kstep;
            const char* a3 = a2 + kstep; const char* b3 = b2 + kstep;
            if (last && has_next) S.a_ready(nxt);
            PG8_LDB(B0, 0, 0); PG8_SCHED; PG8_LDA(At, 0, 0); PG8_STAGE(PG8_SA(1, 1), a1 + hstep, voffA);
            PG8_WAIT_L(8); PG8_BAR; PG8_WAIT_L(0); PG8_MMA(0, 0, At, B0); PG8_BAR; PG8_SCHED;
            PG8_LDB(B1, 0, 1); PG8_STAGE(PG8_SB(0, 0), b2, voffB);
            PG8_BAR; PG8_WAIT_L(0); PG8_MMA(0, 1, At, B1); PG8_BAR;
            PG8_LDA(At, 0, 1); PG8_STAGE(PG8_SA(0, 0), a2, voffA);
            PG8_BAR; PG8_WAIT_L(0); PG8_MMA(1, 0, At, B0); PG8_BAR; PG8_SCHED;
            PG8_STAGE(PG8_SB(0, 1), b2 + hstep, voffB);
            PG8_WAIT_V(6); PG8_BAR; PG8_MMA(1, 1, At, B1); PG8_BAR;
            PG8_LDB(B0, 1, 0); PG8_SCHED; PG8_LDA(At, 1, 0); PG8_STAGE(PG8_SA(0, 1), a2 + hstep, voffA);
            PG8_WAIT_L(8); PG8_BAR; PG8_WAIT_L(0); PG8_MMA(0, 0, At, B0); PG8_BAR; PG8_SCHED;
            PG8_LDB(B1, 1, 1); PG8_STAGE(PG8_SB(1, 0), b3, voffB);
            PG8_BAR; PG8_WAIT_L(0); PG8_MMA(0, 1, At, B1); PG8_BAR;
            PG8_LDA(At, 1, 1); PG8_STAGE(PG8_SA(1, 0), a3, voffA);
            PG8_BAR; PG8_WAIT_L(0); PG8_MMA(1, 0, At, B0); PG8_BAR; PG8_SCHED;
            PG8_STAGE(PG8_SB(1, 1), b3 + hstep, voffB);
            PG8_WAIT_V(6); PG8_BAR; PG8_MMA(1, 1, At, B1); PG8_BAR;
        }
        PG8_STAMP();
        if constexpr (!Epi::AFTER_DRAIN) { E(acc, cur, wr, wc, fr, fq); S.done(cur); }
        PG8_STAMP();
        if (!has_next) break;
#pragma unroll
        for (int a = 0; a < 2; ++a)
#pragma unroll
            for (int b = 0; b < 2; ++b)
#pragma unroll
                for (int m = 0; m < 4; ++m)
#pragma unroll
                    for (int n = 0; n < 2; ++n) acc[a][b][m][n] = (f32x4){0.f, 0.f, 0.f, 0.f};
        cur = nxt; cA = nA; cB = nB; ++ui;
    }
    PG8_WAIT_V(0);
    if (wr == 0) PG8_BAR;
    PG8_BAR;
    if constexpr (Epi::AFTER_DRAIN) { E.fused(acc, cur, wr, wc, fr, fq, lds, wid, lane); S.done(cur); }
    PG8_STAMP();
    if (STAMP && wid == 0) { stamps[lane] = lane < nts ? (((unsigned long long)(unsigned)ts_hi << 32) | (unsigned)ts_lo) : 0ull;
        if (lane == 62) stamps[62] = rt_entry; if (lane == 63) stamps[63] = (unsigned long long)wall_clock64(); }
#undef PG8_STAMP
#undef PG8_SA
#undef PG8_SB
#undef PG8_STAGE
#undef PG8_LDA
#undef PG8_LDB
#undef PG8_MMA
#undef PG8_WAIT_V
#undef PG8_WAIT_L
#undef PG8_BAR
#undef PG8_SCHED
}
}
typedef unsigned short bf16_t;
typedef short bf16x8 __attribute__((ext_vector_type(8)));
typedef float f32x4 __attribute__((ext_vector_type(4)));
typedef float f32x16 __attribute__((ext_vector_type(16)));
typedef unsigned u32x4 __attribute__((ext_vector_type(4)));
typedef unsigned u32x2 __attribute__((ext_vector_type(2)));
#define LAS __attribute__((address_space(3)))

constexpr int DM = 1024, NCOL = 3584, DFF = 2816, NFF = 5632;
constexpr int GT = 16384;
constexpr int NGROUP = 4, DEPTH = 2;
constexpr int NTHR = 512;
constexpr int LDS_BYTES = 131072;
constexpr float EPS = 1e-6f;
constexpr int C_Q = 0, C_FF = 512, C_FB = 1024, C_I = 1536, C_G = 2048, C_U = 2560, C_V = 3072;

constexpr size_t SZ_WIN = (size_t)NCOL * DM * 2, SZ_WOUT = (size_t)DM * DM * 2, SZ_WFI = (size_t)NFF * DM * 2, SZ_WFO = (size_t)DM * DFF * 2;
constexpr size_t WS_WIN = 0;
constexpr size_t WS_WOUT = WS_WIN + 2 * SZ_WIN;
constexpr size_t WS_WFI = WS_WOUT + 2 * SZ_WOUT;
constexpr size_t WS_WFO = WS_WFI + 2 * SZ_WFI;
constexpr size_t WS_H = WS_WFO + 2 * SZ_WFO;
constexpr size_t WS_PROJ = WS_H + (size_t)GT * DM * 2;
constexpr size_t WS_US = WS_PROJ + (size_t)GT * NFF * 2;
constexpr size_t WS_D = WS_US + (size_t)256 * 8 * 16384 * 2;
constexpr size_t WS_MIX = WS_D + (size_t)256 * 8 * 128 * 4;
constexpr size_t WS_ACT = WS_MIX + (size_t)GT * DM * 2;
constexpr size_t WS_END = WS_ACT + (size_t)GT * DFF * 2;

struct Params {
    const float* x_prompt; const float* x_sample; const float* norm1_g; const float* w_in; const float* lb_logits; const float* hg_norm_g;
    const float* sg_norm_g; const float* sg_norm_b; const float* sg_w; const float* sg_b; const float* w_out; const float* norm2_g;
    const float* w_ffn_in; const float* conv_w; const float* conv_b; const float* w_ffn_out; const float* final_g;
    float* out; unsigned char* ws; int ph_lo, ph_hi;
};

typedef __bf16 bf16x2_t __attribute__((ext_vector_type(2)));
typedef float f32x2_t __attribute__((ext_vector_type(2)));
__device__ __forceinline__ unsigned pk2(float lo, float hi) { f32x2_t v = {lo, hi}; bf16x2_t b = __builtin_convertvector(v, bf16x2_t); return __builtin_bit_cast(unsigned, b); }
__device__ __forceinline__ float bf2f(unsigned short b) { return __uint_as_float(((unsigned)b) << 16); }
__device__ __forceinline__ float bflo(unsigned w) { return __uint_as_float(w << 16); }
__device__ __forceinline__ float bfhi(unsigned w) { return __uint_as_float(w & 0xffff0000u); }
__device__ __forceinline__ float fast_exp(float x) { return __expf(x); }
__device__ __forceinline__ float gelu_t(float x) { const float y = 1.5957691216f * (x + 0.044715f * x * x * x); return x / (1.0f + __expf(-y)); }
__device__ __forceinline__ float silu_f(float x) { return x / (1.0f + __expf(-x)); }
__device__ __forceinline__ float wave_sum(float v) {
#pragma unroll
    for (int o = 32; o > 0; o >>= 1) v += __shfl_xor(v, o, 64);
    return v;
}

struct EpiB16 {
    static constexpr bool PERM = true, AFTER_DRAIN = false;
    bf16_t* O; int ldc;
    __device__ __forceinline__ void operator()(const f32x4 (&acc)[2][2][4][2], const pg8::Unit& u, int wr, int wc, int fr, int fq) const {
        const int row0 = u.pm * 256 + wr * 64 + fr, col0 = u.pn * 256 + wc * 32 + 8 * fq;
#pragma unroll
        for (int ai = 0; ai < 2; ++ai)
#pragma unroll
            for (int m = 0; m < 4; ++m) {
                bf16_t* rowp = O + (size_t)(row0 + ai * 128 + m * 16) * ldc + col0;
#pragma unroll
                for (int bj = 0; bj < 2; ++bj) {
                    const f32x4 v0 = acc[ai][bj][m][0], v1 = acc[ai][bj][m][1];
                    u32x4 o; o[0] = pk2(v0[0], v0[1]); o[1] = pk2(v0[2], v0[3]); o[2] = pk2(v1[0], v1[1]); o[3] = pk2(v1[2], v1[3]);
                    *(u32x4*)(rowp + bj * 128) = o;
                }
            }
    }
};
struct EpiRes {
    static constexpr bool PERM = false, AFTER_DRAIN = false;
    const float* R; float* X;
    __device__ __forceinline__ void operator()(const f32x4 (&acc)[2][2][4][2], const pg8::Unit& u, int wr, int wc, int fr, int fq) const {
        const int row0 = u.pm * 256 + wr * 64 + fr, col0 = u.pn * 256 + wc * 32 + 4 * fq;
#pragma unroll
        for (int ai = 0; ai < 2; ++ai)
#pragma unroll
            for (int m = 0; m < 4; ++m) {
                const size_t off = (size_t)(row0 + ai * 128 + m * 16) * DM + col0;
#pragma unroll
                for (int bj = 0; bj < 2; ++bj)
#pragma unroll
                    for (int n = 0; n < 2; ++n) {
                        const size_t o = off + bj * 128 + n * 16;
                        const f32x4 r = *(const f32x4*)(R + o);
                        *(f32x4*)(X + o) = r + acc[ai][bj][m][n];
                    }
            }
    }
};

__device__ __forceinline__ void transpose_convert(LAS unsigned char* lds, const float* src, bf16_t* dst, int K, int N, int tile0, int tstride) {
    LAS float* T = (LAS float*)lds;
    const int tid = mk_tid();
    const int ntn = N / 64, ntk = K / 64, ntiles = ntn * ntk;
    for (int t = tile0; t < ntiles; t += tstride) {
        const int tk = t / ntn, tn = t % ntn;
        {
            const int r = tid >> 3, c = (tid & 7) * 8;
            const float* s = src + (size_t)(tk * 64 + r) * N + tn * 64 + c;
            const f32x4 a = *(const f32x4*)s, b = *(const f32x4*)(s + 4);
            LAS float* d = T + r * 65 + c;
            d[0] = a[0]; d[1] = a[1]; d[2] = a[2]; d[3] = a[3]; d[4] = b[0]; d[5] = b[1]; d[6] = b[2]; d[7] = b[3];
        }
        __syncthreads();
        {
            const int n = tid >> 3, k0 = (tid & 7) * 8;
            float v[8];
#pragma unroll
            for (int j = 0; j < 8; ++j) v[j] = T[(k0 + j) * 65 + n];
            u32x4 o; o[0] = pk2(v[0], v[1]); o[1] = pk2(v[2], v[3]); o[2] = pk2(v[4], v[5]); o[3] = pk2(v[6], v[7]);
            *(u32x4*)(dst + (size_t)(tn * 64 + n) * K + tk * 64 + k0) = o;
        }
        __syncthreads();
    }
}

__device__ __forceinline__ void rmsnorm_rows(const float* src, const float* gam, bf16_t* dstb, float* dstf, int rows) {
    const int lane = mk_tid() & 63, wave = mk_tid() >> 6;
    f32x4 gv[4];
#pragma unroll
    for (int i = 0; i < 4; ++i) gv[i] = *(const f32x4*)(gam + lane * 4 + i * 256);
    for (int row = mk_bid() * 8 + wave; row < rows; row += gridDim.x * 8) {
        const float* s = src + (size_t)row * DM;
        f32x4 v[4]; float ss = 0.f;
#pragma unroll
        for (int i = 0; i < 4; ++i) { v[i] = *(const f32x4*)(s + lane * 4 + i * 256); ss += v[i][0] * v[i][0] + v[i][1] * v[i][1] + v[i][2] * v[i][2] + v[i][3] * v[i][3]; }
        ss = wave_sum(ss);
        const float rstd = rsqrtf(ss * (1.0f / DM) + EPS);
#pragma unroll
        for (int i = 0; i < 4; ++i) {
            f32x4 y = v[i] * rstd * gv[i];
            if (dstb) { u32x2 o; o[0] = pk2(y[0], y[1]); o[1] = pk2(y[2], y[3]); *(u32x2*)(dstb + (size_t)row * DM + lane * 4 + i * 256) = o; }
            else {
#ifdef DBG_SANITIZE
                for (int e = 0; e < 4; ++e) if (!(fabsf(y[e]) < 1e30f)) y[e] = 0.f;
#endif
                *(f32x4*)(dstf + (size_t)row * DM + lane * 4 + i * 256) = y; }
        }
    }
}

__device__ __forceinline__ bf16x8 lds_frag(const LAS bf16_t* base, int row, int ld, int k) { return *(const LAS bf16x8*)(base + row * ld + k); }

constexpr int NAT_LD = 136, T64_LD = 72;
__device__ __forceinline__ void stage_nat(LAS bf16_t* NAT, const bf16_t* g) {
    const int tid = mk_tid(), r = tid >> 3, c = (tid & 7) * 16;
    const u32x4 a = *(const u32x4*)(g + (size_t)r * NCOL + c), b = *(const u32x4*)(g + (size_t)r * NCOL + c + 8);
    *(LAS u32x4*)(NAT + r * NAT_LD + c) = a; *(LAS u32x4*)(NAT + r * NAT_LD + c + 8) = b;
}
__device__ __forceinline__ void gate16(const LAS bf16_t* NAT, int c, int seg, float lb, int dir, float (&b)[16], float (&kk)[16], float& tot) {
    float lf[16];
#pragma unroll
    for (int j = 0; j < 16; ++j) {
        const float z = bf2f(NAT[(seg * 16 + j) * NAT_LD + c]);
        const float e = __expf(-fabsf(z)), s = 1.0f / (1.0f + e);
        const float sig = z >= 0.f ? s : e * s, nsig = z >= 0.f ? e * s : s;
        const float f = lb + (1.0f - lb) * sig;
        lf[j] = __logf(f);
        kk[j] = (1.0f - lb) * nsig;
    }
    if (dir == 0) { float a = 0.f;
#pragma unroll
        for (int j = 0; j < 16; ++j) { a += lf[j]; b[j] = a; } tot = a; }
    else { float a = 0.f;
#pragma unroll
        for (int j = 15; j >= 0; --j) { a += lf[j]; b[j] = a; } tot = a; }
}
__device__ __forceinline__ float lb_value(const Params& p, int l, int dir, int ch) {
    if (l == 0) return 0.f;
    const float l0 = p.lb_logits[(dir * 2 + 0) * 512 + ch], l1 = p.lb_logits[(dir * 2 + 1) * 512 + ch];
    return 1.0f / (1.0f + __expf(l0 - l1));
}

constexpr int L_NAT = 0;
constexpr int L_VT = 17408;
constexpr int L_KT = L_VT + 18432;
constexpr int L_TOT = L_KT + 18432;
constexpr int L_QS = L_TOT + 2048;
constexpr int L_KS = L_QS + 17408;
constexpr int L_QI = L_KS + 17408;
constexpr int L_PS = L_QI + 17408;
constexpr int L_O = L_QS;
constexpr int L_HG_END = L_PS + 9216;
static_assert(L_HG_END <= LDS_BYTES, "lds");

__device__ void hgrn_states(LAS unsigned char* lds, const Params& p, int l, const bf16_t* proj, bf16_t* US, float* Dd) {
    LAS bf16_t* NAT = (LAS bf16_t*)(lds + L_NAT); LAS bf16_t* VT = (LAS bf16_t*)(lds + L_VT); LAS bf16_t* KT = (LAS bf16_t*)(lds + L_KT);
    LAS float* TOT = (LAS float*)(lds + L_TOT);
    const int tid = mk_tid(), lane = tid & 63, wave = tid >> 6, c = tid & 127, seg = tid >> 7;
    for (int item = mk_bid(); item < 256 * 4; item += gridDim.x) {
        const int cg_ = item >> 2, h = item & 3;
        const bf16_t* base = proj + (size_t)cg_ * 64 * NCOL + h * 128;
        stage_nat(NAT, base + C_I);
        __syncthreads();
        {
            unsigned w[8];
#pragma unroll
            for (int j = 0; j < 8; ++j) w[j] = (unsigned)NAT[(seg * 16 + 2 * j) * NAT_LD + c] | ((unsigned)NAT[(seg * 16 + 2 * j + 1) * NAT_LD + c] << 16);
            u32x4 a, b; a[0] = w[0]; a[1] = w[1]; a[2] = w[2]; a[3] = w[3]; b[0] = w[4]; b[1] = w[5]; b[2] = w[6]; b[3] = w[7];
            *(LAS u32x4*)(VT + c * T64_LD + seg * 16) = a; *(LAS u32x4*)(VT + c * T64_LD + seg * 16 + 8) = b;
        }
        __syncthreads();
        for (int dir = 0; dir < 2; ++dir) {
            stage_nat(NAT, base + (dir ? C_FB : C_FF));
            __syncthreads();
            const float lb = lb_value(p, l, dir, h * 128 + c);
            float b[16], kk[16], tot;
            gate16(NAT, c, seg, lb, dir, b, kk, tot);
            TOT[seg * 128 + c] = tot;
            __syncthreads();
            float off = 0.f, total = 0.f;
#pragma unroll
            for (int s = 0; s < 4; ++s) { const float t = TOT[s * 128 + c]; total += t; if (dir == 0 ? (s < seg) : (s > seg)) off += t; }
            {
                unsigned w[8];
#pragma unroll
                for (int j = 0; j < 8; ++j) {
                    const float k0 = kk[2 * j] * __expf(total - (b[2 * j] + off)), k1 = kk[2 * j + 1] * __expf(total - (b[2 * j + 1] + off));
                    w[j] = pk2(k0, k1);
                }
                u32x4 a, bb; a[0] = w[0]; a[1] = w[1]; a[2] = w[2]; a[3] = w[3]; bb[0] = w[4]; bb[1] = w[5]; bb[2] = w[6]; bb[3] = w[7];
                *(LAS u32x4*)(KT + c * T64_LD + seg * 16) = a; *(LAS u32x4*)(KT + c * T64_LD + seg * 16 + 8) = bb;
            }
            const size_t sidx = (size_t)(item * 2 + dir);
            if (seg == 0) Dd[sidx * 128 + c] = __expf(total);
            __syncthreads();
            const int mb = wave & 3, nh = wave >> 2, lr = lane & 31, lh = lane >> 5;
            f32x16 acc0 = {}, acc1 = {};
#pragma unroll
            for (int ks = 0; ks < 4; ++ks) {
                const bf16x8 af = lds_frag(KT, mb * 32 + lr, T64_LD, ks * 16 + lh * 8);
                const bf16x8 b0 = lds_frag(VT, nh * 64 + lr, T64_LD, ks * 16 + lh * 8);
                const bf16x8 b1 = lds_frag(VT, nh * 64 + 32 + lr, T64_LD, ks * 16 + lh * 8);
                acc0 = __builtin_amdgcn_mfma_f32_32x32x16_bf16(af, b0, acc0, 0, 0, 0);
                acc1 = __builtin_amdgcn_mfma_f32_32x32x16_bf16(af, b1, acc1, 0, 0, 0);
            }
            bf16_t* Ub = US + sidx * 16384;
#pragma unroll
            for (int i = 0; i < 4; ++i) {
                const int k = mb * 32 + 8 * i + 4 * lh;
                u32x2 o0, o1; o0[0] = pk2(acc0[4 * i], acc0[4 * i + 1]); o0[1] = pk2(acc0[4 * i + 2], acc0[4 * i + 3]);
                o1[0] = pk2(acc1[4 * i], acc1[4 * i + 1]); o1[1] = pk2(acc1[4 * i + 2], acc1[4 * i + 3]);
                *(u32x2*)(Ub + (size_t)(nh * 64 + lr) * 128 + k) = o0;
                *(u32x2*)(Ub + (size_t)(nh * 64 + 32 + lr) * 128 + k) = o1;
            }
            __syncthreads();
        }
    }
}

__device__ void hgrn_scan(int g, bf16_t* US, const float* Dd) {
    const int NC = g < 2 ? 64 : 256, NSEQ = g < 2 ? 4 : 1;
    const int nitems = NSEQ * 8 * 8192;
    for (int item = mk_bid() * NTHR + mk_tid(); item < nitems; item += gridDim.x * NTHR) {
        const int e2 = item & 8191, sq = item >> 13, dir = sq & 1, h = (sq >> 1) & 3, s = sq >> 3;
        const int k = (e2 * 2) & 127;
        float s0 = 0.f, s1 = 0.f;
        const int n0 = dir == 0 ? 0 : NC - 1, dn = dir == 0 ? 1 : -1;
        for (int nb = 0; nb < NC; nb += 8) {
            unsigned u[8]; float d0[8], d1[8];
#pragma unroll
            for (int j = 0; j < 8; ++j) {
                const int n = n0 + dn * (nb + j);
                const size_t sidx = ((size_t)(s * NC + n) * 4 + h) * 2 + dir;
                u[j] = *(const unsigned*)(US + sidx * 16384 + e2 * 2);
                const float2 dd = *(const float2*)(Dd + sidx * 128 + k);
                d0[j] = dd.x; d1[j] = dd.y;
            }
#pragma unroll
            for (int j = 0; j < 8; ++j) {
                const int n = n0 + dn * (nb + j);
                const size_t sidx = ((size_t)(s * NC + n) * 4 + h) * 2 + dir;
                *(unsigned*)(US + sidx * 16384 + e2 * 2) = pk2(s0, s1);
                s0 = d0[j] * s0 + bflo(u[j]); s1 = d1[j] * s1 + bfhi(u[j]);
            }
        }
    }
}

__device__ void hgrn_out(LAS unsigned char* lds, const Params& p, int l, const bf16_t* proj, const bf16_t* US, bf16_t* mix) {
    LAS bf16_t* NAT = (LAS bf16_t*)(lds + L_NAT); LAS bf16_t* VT = (LAS bf16_t*)(lds + L_VT);
    LAS float* TOT = (LAS float*)(lds + L_TOT);
    LAS bf16_t* QS = (LAS bf16_t*)(lds + L_QS); LAS bf16_t* KS = (LAS bf16_t*)(lds + L_KS); LAS bf16_t* QI = (LAS bf16_t*)(lds + L_QI);
    LAS bf16_t* PS = (LAS bf16_t*)(lds + L_PS); LAS float* OL = (LAS float*)(lds + L_O);
    const int tid = mk_tid(), lane = tid & 63, wave = tid >> 6, c = tid & 127, seg = tid >> 7;
    for (int item = mk_bid(); item < 256 * 4; item += gridDim.x) {
        const int cg_ = item >> 2, h = item & 3;
        const bf16_t* base = proj + (size_t)cg_ * 64 * NCOL + h * 128;
        stage_nat(NAT, base + C_I);
        __syncthreads();
        {
            unsigned w[8];
#pragma unroll
            for (int j = 0; j < 8; ++j) w[j] = (unsigned)NAT[(seg * 16 + 2 * j) * NAT_LD + c] | ((unsigned)NAT[(seg * 16 + 2 * j + 1) * NAT_LD + c] << 16);
            u32x4 a, b; a[0] = w[0]; a[1] = w[1]; a[2] = w[2]; a[3] = w[3]; b[0] = w[4]; b[1] = w[5]; b[2] = w[6]; b[3] = w[7];
            *(LAS u32x4*)(VT + c * T64_LD + seg * 16) = a; *(LAS u32x4*)(VT + c * T64_LD + seg * 16 + 8) = b;
        }
        __syncthreads();
        stage_nat(NAT, base + C_Q);
        __syncthreads();
        float qv[16];
#pragma unroll
        for (int j = 0; j < 16; ++j) qv[j] = bf2f(NAT[(seg * 16 + j) * NAT_LD + c]);
        __syncthreads();
        const int tb = wave & 1, vb = wave >> 1, lr = lane & 31, lh = lane >> 5;
        f32x16 oacc = {};
        for (int dir = 0; dir < 2; ++dir) {
            stage_nat(NAT, base + (dir ? C_FB : C_FF));
            __syncthreads();
            const float lb = lb_value(p, l, dir, h * 128 + c);
            float b[16], kk[16], tot;
            gate16(NAT, c, seg, lb, dir, b, kk, tot);
            TOT[seg * 128 + c] = tot;
            __syncthreads();
            float off = 0.f, ref;
            { const float t0 = TOT[c], t1 = TOT[128 + c], t2 = TOT[256 + c], t3 = TOT[384 + c];
              if (dir == 0) { off = (seg > 0 ? t0 : 0.f) + (seg > 1 ? t1 : 0.f) + (seg > 2 ? t2 : 0.f); ref = t0 + t1; }
              else { off = (seg < 3 ? t3 : 0.f) + (seg < 2 ? t2 : 0.f) + (seg < 1 ? t1 : 0.f); ref = t2 + t3; } }
#pragma unroll
            for (int j = 0; j < 16; ++j) {
                const float bj = b[j] + off;
                const int t = seg * 16 + j;
                const float qs = qv[j] * __expf(bj - ref), ks = kk[j] * __expf(ref - bj), qi = qv[j] * __expf(bj);
                QS[t * NAT_LD + c] = (bf16_t)(pk2(qs, 0.f) & 0xffffu);
                KS[t * NAT_LD + c] = (bf16_t)(pk2(ks, 0.f) & 0xffffu);
                QI[t * NAT_LD + c] = (bf16_t)(pk2(qi, 0.f) & 0xffffu);
            }
            __syncthreads();
            {
                const int tm = wave & 3, tn0 = (wave >> 2) * 2, r16 = lane & 15, q4 = lane >> 4;
                f32x4 s0 = {}, s1 = {};
#pragma unroll
                for (int ks = 0; ks < 4; ++ks) {
                    const bf16x8 af = lds_frag(QS, tm * 16 + r16, NAT_LD, ks * 32 + q4 * 8);
                    const bf16x8 b0 = lds_frag(KS, tn0 * 16 + r16, NAT_LD, ks * 32 + q4 * 8);
                    const bf16x8 b1 = lds_frag(KS, tn0 * 16 + 16 + r16, NAT_LD, ks * 32 + q4 * 8);
                    s0 = __builtin_amdgcn_mfma_f32_16x16x32_bf16(af, b0, s0, 0, 0, 0);
                    s1 = __builtin_amdgcn_mfma_f32_16x16x32_bf16(af, b1, s1, 0, 0, 0);
                }
#pragma unroll
                for (int r = 0; r < 4; ++r) {
                    const int t = tm * 16 + q4 * 4 + r, sa = tn0 * 16 + r16, sb = sa + 16;
                    const bool ka = dir == 0 ? (sa <= t) : (sa >= t), kb = dir == 0 ? (sb <= t) : (sb >= t);
                    PS[t * T64_LD + sa] = (bf16_t)(pk2(ka ? s0[r] : 0.f, 0.f) & 0xffffu);
                    PS[t * T64_LD + sb] = (bf16_t)(pk2(kb ? s1[r] : 0.f, 0.f) & 0xffffu);
                }
            }
            __syncthreads();
            const bf16_t* Sg = US + (size_t)(item * 2 + dir) * 16384 + (size_t)(vb * 32 + lr) * 128 + lh * 8;
            bf16x8 sf[8];
#pragma unroll
            for (int ks = 0; ks < 8; ++ks) sf[ks] = *(const bf16x8*)(Sg + ks * 16);
#pragma unroll
            for (int ks = 0; ks < 4; ++ks) {
                const bf16x8 af = lds_frag(PS, tb * 32 + lr, T64_LD, ks * 16 + lh * 8);
                const bf16x8 bfm = lds_frag(VT, vb * 32 + lr, T64_LD, ks * 16 + lh * 8);
                oacc = __builtin_amdgcn_mfma_f32_32x32x16_bf16(af, bfm, oacc, 0, 0, 0);
            }
#pragma unroll
            for (int ks = 0; ks < 8; ++ks) {
                const bf16x8 af = lds_frag(QI, tb * 32 + lr, NAT_LD, ks * 16 + lh * 8);
                oacc = __builtin_amdgcn_mfma_f32_32x32x16_bf16(af, sf[ks], oacc, 0, 0, 0);
            }
            __syncthreads();
        }
#pragma unroll
        for (int i = 0; i < 4; ++i)
#pragma unroll
            for (int j = 0; j < 4; ++j) OL[(tb * 32 + 8 * i + 4 * lh + j) * 132 + vb * 32 + lr] = oacc[4 * i + j];
        __syncthreads();
        {
            const int t = tid >> 3, v0 = (tid & 7) * 16;
            float ov[16]; float ss = 0.f;
#pragma unroll
            for (int j = 0; j < 16; ++j) { ov[j] = OL[t * 132 + v0 + j]; ss += ov[j] * ov[j]; }
            ss += __shfl_xor(ss, 1, 64); ss += __shfl_xor(ss, 2, 64); ss += __shfl_xor(ss, 4, 64);
            const float rstd = rsqrtf(ss * (1.0f / 128.f) + EPS);
            const bf16_t* gp = base + (size_t)t * NCOL + C_G + v0;
            const u32x4 g0 = *(const u32x4*)gp, g1 = *(const u32x4*)(gp + 8);
            const float* gn = p.hg_norm_g + l * 512 + h * 128 + v0;
            unsigned w[8];
#pragma unroll
            for (int j = 0; j < 8; ++j) {
                const unsigned gw = j < 4 ? g0[j] : g1[j - 4];
                const float y0 = ov[2 * j] * rstd * gn[2 * j] * silu_f(bflo(gw)), y1 = ov[2 * j + 1] * rstd * gn[2 * j + 1] * silu_f(bfhi(gw));
                w[j] = pk2(y0, y1);
            }
            u32x4 a, bb; a[0] = w[0]; a[1] = w[1]; a[2] = w[2]; a[3] = w[3]; bb[0] = w[4]; bb[1] = w[5]; bb[2] = w[6]; bb[3] = w[7];
            bf16_t* mp = mix + (size_t)(cg_ * 64 + t) * DM + h * 128 + v0;
            *(u32x4*)mp = a; *(u32x4*)(mp + 8) = bb;
        }
        __syncthreads();
    }
}

constexpr int L_WS = 0, L_VT2 = 34816;
__device__ void sg_items(LAS unsigned char* lds, const Params& p, int l, const bf16_t* proj, bf16_t* mix) {
    LAS bf16_t* WS = (LAS bf16_t*)(lds + L_WS); LAS bf16_t* VT2 = (LAS bf16_t*)(lds + L_VT2);
    const int tid = mk_tid(), lane = tid & 63, wave = tid >> 6;
    for (int item = mk_bid(); item < 128 * 4; item += gridDim.x) {
        const int ck = item >> 2, h = item & 3;
        {
            const int r = tid >> 2, c0 = (tid & 3) * 32;
            const float* s = p.sg_w + ((size_t)(l * 4 + h) * 128 + r) * 128 + c0;
#pragma unroll
            for (int q = 0; q < 4; ++q) {
                const f32x4 a = *(const f32x4*)(s + q * 8), b = *(const f32x4*)(s + q * 8 + 4);
                u32x4 o; o[0] = pk2(a[0], a[1]); o[1] = pk2(a[2], a[3]); o[2] = pk2(b[0], b[1]); o[3] = pk2(b[2], b[3]);
                *(LAS u32x4*)(WS + r * NAT_LD + c0 + q * 8) = o;
            }
        }
        {
            const int pos = tid >> 2, q0 = (tid & 3) * 32;
            const bf16_t* vp = proj + (size_t)(ck * 128 + pos) * NCOL + C_V + h * 128 + q0;
            float x[32]; float sum = 0.f;
#pragma unroll
            for (int q = 0; q < 4; ++q) {
                const u32x4 a = *(const u32x4*)(vp + q * 8);
#pragma unroll
                for (int j = 0; j < 4; ++j) { x[q * 8 + 2 * j] = gelu_t(bflo(a[j])); x[q * 8 + 2 * j + 1] = gelu_t(bfhi(a[j])); }
            }
#pragma unroll
            for (int j = 0; j < 32; ++j) sum += x[j];
            sum += __shfl_xor(sum, 1, 64); sum += __shfl_xor(sum, 2, 64);
            const float mu = sum * (1.0f / 128.f);
            float var = 0.f;
#pragma unroll
            for (int j = 0; j < 32; ++j) { x[j] -= mu; var += x[j] * x[j]; }
            var += __shfl_xor(var, 1, 64); var += __shfl_xor(var, 2, 64);
            const float rstd = rsqrtf(var * (1.0f / 128.f) + EPS);
            const float* gm = p.sg_norm_g + l * 512 + h * 128 + q0; const float* bt = p.sg_norm_b + l * 512 + h * 128 + q0;
#pragma unroll
            for (int j = 0; j < 32; ++j) {
                const float y = x[j] * rstd * gm[j] + bt[j];
                VT2[(q0 + j) * NAT_LD + pos] = (bf16_t)(pk2(y, 0.f) & 0xffffu);
            }
        }
        __syncthreads();
        const int mb = wave & 3, nh = wave >> 2, lr = lane & 31, lh = lane >> 5;
        f32x16 acc0 = {}, acc1 = {};
#pragma unroll
        for (int ks = 0; ks < 8; ++ks) {
            const bf16x8 af = lds_frag(VT2, mb * 32 + lr, NAT_LD, ks * 16 + lh * 8);
            const bf16x8 b0 = lds_frag(WS, nh * 64 + lr, NAT_LD, ks * 16 + lh * 8);
            const bf16x8 b1 = lds_frag(WS, nh * 64 + 32 + lr, NAT_LD, ks * 16 + lh * 8);
            acc0 = __builtin_amdgcn_mfma_f32_32x32x16_bf16(af, b0, acc0, 0, 0, 0);
            acc1 = __builtin_amdgcn_mfma_f32_32x32x16_bf16(af, b1, acc1, 0, 0, 0);
        }
#pragma unroll
        for (int nt = 0; nt < 2; ++nt) {
            const int pp = nh * 64 + nt * 32 + lr;
            const float bs = p.sg_b[(l * 4 + h) * 128 + pp];
            const bf16_t* up = proj + (size_t)(ck * 128 + pp) * NCOL + C_U + h * 128;
            bf16_t* mp = mix + (size_t)(ck * 128 + pp) * DM + 512 + h * 128;
#pragma unroll
            for (int i = 0; i < 4; ++i) {
                const int d = mb * 32 + 8 * i + 4 * lh;
                const u32x2 uw = *(const u32x2*)(up + d);
                const float a0 = (nt ? acc1[4 * i] : acc0[4 * i]) + bs, a1 = (nt ? acc1[4 * i + 1] : acc0[4 * i + 1]) + bs;
                const float a2 = (nt ? acc1[4 * i + 2] : acc0[4 * i + 2]) + bs, a3 = (nt ? acc1[4 * i + 3] : acc0[4 * i + 3]) + bs;
                u32x2 o; o[0] = pk2(gelu_t(bflo(uw[0])) * a0, gelu_t(bfhi(uw[0])) * a1); o[1] = pk2(gelu_t(bflo(uw[1])) * a2, gelu_t(bfhi(uw[1])) * a3);
                *(u32x2*)(mp + d) = o;
            }
        }
        __syncthreads();
    }
}

__device__ void conv_gate(const Params& p, int l, int g, const bf16_t* a, bf16_t* act) {
    const int SL = g < 2 ? 4096 : 16384;
    constexpr int CG = DFF / 8, TR = 16;
    const int nitems = CG * (GT / TR);
    const float* cw = p.conv_w + (size_t)l * 3 * NFF; const float* cb = p.conv_b + (size_t)l * NFF;
    for (int item = mk_bid() * NTHR + mk_tid(); item < nitems; item += gridDim.x * NTHR) {
        const int cgp = item % CG, tr = item / CG, c0 = cgp * 8, t0 = tr * TR;
        float w[2][3][8], bb[2][8];
#pragma unroll
        for (int s = 0; s < 2; ++s) {
#pragma unroll
            for (int k = 0; k < 3; ++k) { const f32x4 x0 = *(const f32x4*)(cw + k * NFF + s * DFF + c0), x1 = *(const f32x4*)(cw + k * NFF + s * DFF + c0 + 4);
#pragma unroll
                for (int j = 0; j < 4; ++j) { w[s][k][j] = x0[j]; w[s][k][4 + j] = x1[j]; } }
            const f32x4 y0 = *(const f32x4*)(cb + s * DFF + c0), y1 = *(const f32x4*)(cb + s * DFF + c0 + 4);
#pragma unroll
            for (int j = 0; j < 4; ++j) { bb[s][j] = y0[j]; bb[s][4 + j] = y1[j]; }
        }
        u32x4 prv[2], cur[2], nxt[2];
        const u32x4 zero = {0u, 0u, 0u, 0u};
#pragma unroll
        for (int s = 0; s < 2; ++s) {
            prv[s] = (t0 % SL == 0) ? zero : *(const u32x4*)(a + (size_t)(t0 - 1) * NFF + s * DFF + c0);
            cur[s] = *(const u32x4*)(a + (size_t)t0 * NFF + s * DFF + c0);
        }
#pragma unroll 4
        for (int i = 0; i < TR; ++i) {
            const int t = t0 + i;
#pragma unroll
            for (int s = 0; s < 2; ++s) nxt[s] = ((t + 1) % SL == 0) ? zero : *(const u32x4*)(a + (size_t)(t + 1) * NFF + s * DFF + c0);
            float r[2][8];
#pragma unroll
            for (int s = 0; s < 2; ++s)
#pragma unroll
                for (int j = 0; j < 4; ++j) {
                    r[s][2 * j] = w[s][0][2 * j] * bflo(prv[s][j]) + w[s][1][2 * j] * bflo(cur[s][j]) + w[s][2][2 * j] * bflo(nxt[s][j]) + bb[s][2 * j];
                    r[s][2 * j + 1] = w[s][0][2 * j + 1] * bfhi(prv[s][j]) + w[s][1][2 * j + 1] * bfhi(cur[s][j]) + w[s][2][2 * j + 1] * bfhi(nxt[s][j]) + bb[s][2 * j + 1];
                }
            u32x4 o;
#pragma unroll
            for (int j = 0; j < 4; ++j) o[j] = pk2(silu_f(r[0][2 * j]) * r[1][2 * j], silu_f(r[0][2 * j + 1]) * r[1][2 * j + 1]);
            *(u32x4*)(act + (size_t)t * DFF + c0) = o;
#pragma unroll
            for (int s = 0; s < 2; ++s) { prv[s] = cur[s]; cur[s] = nxt[s]; }
        }
    }
}

constexpr int NPHASE = 82;

__device__ __forceinline__ void run_phase(LAS unsigned char* lds, const Params& p, int ph) {
    unsigned char* ws = p.ws;
    if (ph == 0) {
        for (int l = 0; l < DEPTH; ++l) {
            transpose_convert(lds, p.w_in + (size_t)l * DM * NCOL, (bf16_t*)(ws + WS_WIN + l * SZ_WIN), DM, NCOL, mk_bid(), gridDim.x);
            transpose_convert(lds, p.w_out + (size_t)l * DM * DM, (bf16_t*)(ws + WS_WOUT + l * SZ_WOUT), DM, DM, mk_bid(), gridDim.x);
            transpose_convert(lds, p.w_ffn_in + (size_t)l * DM * NFF, (bf16_t*)(ws + WS_WFI + l * SZ_WFI), DM, NFF, mk_bid(), gridDim.x);
            transpose_convert(lds, p.w_ffn_out + (size_t)l * DFF * DM, (bf16_t*)(ws + WS_WFO + l * SZ_WFO), DFF, DM, mk_bid(), gridDim.x);
        }
        return;
    }
    if (ph == NPHASE - 1) { rmsnorm_rows(p.out, p.final_g, nullptr, p.out, NGROUP * GT); return; }
    const int q = ph - 1, k = q % 10, gl = q / 10, l = gl & 1, g = gl >> 1;
    float* xg = p.out + (size_t)g * GT * DM;
    const float* xin = (l == 0) ? ((g < 2 ? p.x_prompt : p.x_sample) + (size_t)(g & 1) * GT * DM) : xg;
    bf16_t* H = (bf16_t*)(ws + WS_H); bf16_t* PROJ = (bf16_t*)(ws + WS_PROJ); bf16_t* US = (bf16_t*)(ws + WS_US); float* Dd = (float*)(ws + WS_D);
    bf16_t* MIX = (bf16_t*)(ws + WS_MIX); bf16_t* ACT = (bf16_t*)(ws + WS_ACT);
    switch (k) {
    case 0: rmsnorm_rows(xin, p.norm1_g + l * DM, H, nullptr, GT); break;
    case 6: rmsnorm_rows(xg, p.norm2_g + l * DM, H, nullptr, GT); break;
    case 1: {
        pg8::Gemm gm; gm.A = H; gm.M = GT; gm.K = DM; gm.Bt = (const bf16_t*)(ws + WS_WIN + l * SZ_WIN); gm.N = NCOL;
        pg8::StaticOrder S; S.init(GT, NCOL, gridDim.x, mk_bid());
        EpiB16 E; E.O = PROJ; E.ldc = NCOL;
        pg8::gemm_phase<EpiB16, pg8::StaticOrder, false>(lds, gm, S, E, nullptr);
    } break;
    case 7: {
        pg8::Gemm gm; gm.A = H; gm.M = GT; gm.K = DM; gm.Bt = (const bf16_t*)(ws + WS_WFI + l * SZ_WFI); gm.N = NFF;
        pg8::StaticOrder S; S.init(GT, NFF, gridDim.x, mk_bid());
        EpiB16 E; E.O = PROJ; E.ldc = NFF;
        pg8::gemm_phase<EpiB16, pg8::StaticOrder, false>(lds, gm, S, E, nullptr);
    } break;
    case 5: {
        pg8::Gemm gm; gm.M = GT; gm.N = DM; gm.A = MIX; gm.Bt = (const bf16_t*)(ws + WS_WOUT + l * SZ_WOUT); gm.K = DM;
        pg8::StaticOrder S; S.init(GT, DM, gridDim.x, mk_bid());
        EpiRes E; E.R = xin; E.X = xg;
        pg8::gemm_phase<EpiRes, pg8::StaticOrder, false>(lds, gm, S, E, nullptr);
    } break;
    case 9: {
        pg8::Gemm gm; gm.M = GT; gm.N = DM; gm.A = ACT; gm.Bt = (const bf16_t*)(ws + WS_WFO + l * SZ_WFO); gm.K = DFF;
        pg8::StaticOrder S; S.init(GT, DM, gridDim.x, mk_bid());
        EpiRes E; E.R = xg; E.X = xg;
        pg8::gemm_phase<EpiRes, pg8::StaticOrder, false>(lds, gm, S, E, nullptr);
    } break;
    case 2: hgrn_states(lds, p, l, PROJ, US, Dd); sg_items(lds, p, l, PROJ, MIX); break;
    case 3: hgrn_scan(g, US, Dd); break;
    case 4: hgrn_out(lds, p, l, PROJ, US, MIX); break;
    case 8: conv_gate(p, l, g, PROJ, ACT); break;
    }
}

#ifdef DBG_STOP
__device__ void dbg_phase(const Params& p, int ph) {
    float* acc = (float*)(p.ws + WS_END);
    const int tid = mk_tid(), bid = mk_bid();
    if (ph == 100) { if (bid == 0 && tid < 2) acc[tid] = 0.f; return; }
    if (ph == 101) {
        const size_t n = (size_t)DBG_N; float ss = 0.f, nf = 0.f;
        for (size_t i = (size_t)bid * NTHR + tid; i < n; i += (size_t)gridDim.x * NTHR) {
#if DBG_F32
            const float v = DBG_F32 == 2 ? p.out[i] : ((const float*)(p.ws + DBG_OFF))[i];
#else
            const float v = bf2f(((const bf16_t*)(p.ws + DBG_OFF))[i]);
#endif
            if (fabsf(v) < 1e30f) ss += v * v; else nf += 1.f;
        }
        ss = wave_sum(ss); nf = wave_sum(nf);
        if ((tid & 63) == 0) { atomicAdd(acc, ss); atomicAdd(acc + 1, nf); }
        return;
    }
    if (ph == 102) {
        const float stat = (DBG_KIND == 0 ? acc[0] : acc[1]) / (float)DBG_N;
        const float c = sqrtf((stat + 1e-6f) * 1e6f);
        for (size_t i = (size_t)bid * NTHR + tid; i < (size_t)NGROUP * GT * DM; i += (size_t)gridDim.x * NTHR) p.out[i] = c;
    }
}
#endif
__global__ void __launch_bounds__(NTHR, 2) mega(Params p) {
    extern __shared__ __attribute__((aligned(16))) unsigned char smem[];
    LAS unsigned char* lds = (LAS unsigned char*)smem;
    cg::grid_group grid = cg::this_grid();
    for (int ph = p.ph_lo; ph < p.ph_hi; ++ph) {
#ifdef DBG_STOP
        if (ph >= 100) { dbg_phase(p, ph); continue; }
#endif
        run_phase(lds, p, ph);
        if (ph + 1 < p.ph_hi) grid.sync();
    }
}

#ifndef ONE_LAUNCH
#define ONE_LAUNCH 0
#endif

extern "C" void kernel_launch(void* const* d_in, const int* in_sizes, int n_in, void* d_out, int out_size, void* d_ws, size_t ws_size, hipStream_t stream) {
    static int grid = 0;
    if (grid == 0) {
        int dev = 0, cus = 0, per_cu = 0;
        hipGetDevice(&dev);
        hipDeviceGetAttribute(&cus, hipDeviceAttributeMultiprocessorCount, dev);
        if (hipFuncSetAttribute((const void*)mega, hipFuncAttributeMaxDynamicSharedMemorySize, LDS_BYTES) != hipSuccess) { fprintf(stderr, "hipFuncSetAttribute failed\n"); grid = -1; return; }
        if (hipOccupancyMaxActiveBlocksPerMultiprocessor(&per_cu, (const void*)mega, NTHR, LDS_BYTES) != hipSuccess || per_cu < 1) { fprintf(stderr, "occupancy query: %d\n", per_cu); per_cu = 1; }
        (void)hipGetLastError();
        grid = cus * 1;
        if (ws_size < WS_END) { fprintf(stderr, "workspace too small: %zu < %zu\n", ws_size, (size_t)WS_END); grid = -1; return; }
    }
    if (grid < 0) return;
    Params p{};
    p.x_prompt = (const float*)d_in[0]; p.x_sample = (const float*)d_in[1]; p.norm1_g = (const float*)d_in[2]; p.w_in = (const float*)d_in[3];
    p.lb_logits = (const float*)d_in[4]; p.hg_norm_g = (const float*)d_in[5]; p.sg_norm_g = (const float*)d_in[6]; p.sg_norm_b = (const float*)d_in[7];
    p.sg_w = (const float*)d_in[8]; p.sg_b = (const float*)d_in[9]; p.w_out = (const float*)d_in[10]; p.norm2_g = (const float*)d_in[11];
    p.w_ffn_in = (const float*)d_in[12]; p.conv_w = (const float*)d_in[13]; p.conv_b = (const float*)d_in[14]; p.w_ffn_out = (const float*)d_in[15];
    p.final_g = (const float*)d_in[16]; p.out = (float*)d_out; p.ws = (unsigned char*)d_ws;
#if ONE_LAUNCH
    p.ph_lo = 0; p.ph_hi = NPHASE;
    void* args[] = {&p};
    hipError_t e = hipLaunchCooperativeKernel((const void*)mega, dim3(grid), dim3(NTHR), args, LDS_BYTES, stream);
    if (e != hipSuccess) fprintf(stderr, "cooperative launch failed: %s (grid %d)\n", hipGetErrorString(e), grid);
#else
#ifdef DBG_STOP
    for (int ph = 0; ph <= 102; ++ph) {
        if (ph > DBG_STOP && ph < 100) continue;
        p.ph_lo = ph; p.ph_hi = ph + 1;
#else
    for (int ph = 0; ph < NPHASE; ++ph) {
        p.ph_lo = ph; p.ph_hi = ph + 1;
#endif
        hipLaunchKernelGGL(mega, dim3(grid), dim3(NTHR), LDS_BYTES, stream, p);
    }
#endif
}
```

```cpp
#include <hip/hip_runtime.h>
#include <hip/hip_cooperative_groups.h>
#include <cstdio>
namespace cg = cooperative_groups;
__device__ __forceinline__ int mk_tid() { int t = threadIdx.x; asm volatile("" : "+v"(t)); return t; }
__device__ __forceinline__ int mk_bid() { int t = blockIdx.x; asm volatile("" : "+s"(t)); return t; }
#define ONE_LAUNCH 1

namespace pg8 {
#define PG8_LAS __attribute__((address_space(3)))
typedef unsigned short bf16_t;
typedef short bf16x8 __attribute__((ext_vector_type(8)));
typedef float f32x4 __attribute__((ext_vector_type(4)));
typedef unsigned u32x4 __attribute__((ext_vector_type(4)));
constexpr int BM = 256, BK = 64, HALF = 128, HTB = HALF * BK * 2  , STAGE_BYTES = 8 * HTB, NXCD = 8, WGM = 2;

__host__ __device__ __forceinline__ int lds_byte(int r, int c) { const int st = (r >> 4) * 2 + (c >> 5), rr = r & 15, cc = c & 31, ob = rr * 64 + cc * 2; return st * 1024 + (ob ^ (((ob >> 9) & 1) << 5)); }
__host__ __device__ __forceinline__ void stage_rc(int b, int& R, int& C) { const int st = b / 1024, sb = b % 1024, swz = sb ^ (((sb >> 9) & 1) << 5); R = (st >> 1) * 16 + swz / 64; C = (st & 1) * 32 + (swz % 64) / 2; }
__host__ __device__ __forceinline__ int perm32(int rho) { const int n = rho >> 4, i = rho & 15; return 8 * (i >> 2) + 4 * n + (i & 3); }

struct Unit { int pm, pn; };
struct Gemm { const bf16_t* A; const bf16_t* Bt; int M, N, K; size_t bh = 0, bt = 0; };

struct StaticOrder {
    int nM, nN, nwg, G, c;
    __host__ __device__ void init(int M, int N, int G_, int c_) { nM = M / BM; nN = N / BM; nwg = nM * nN; G = G_; c = c_; }
    __host__ __device__ bool next(int i, Unit& u) const {
        const long L = (long)i * G + c; if (L >= nwg) return false;
        int wgid = (int)L; { const int q = nwg / NXCD, r = nwg % NXCD, xcd = wgid % NXCD, off = wgid / NXCD; wgid = (xcd < r ? xcd * (q + 1) : r * (q + 1) + (xcd - r) * q) + off; }
        const int nig = WGM * nN, gid = wgid / nig, fm = gid * WGM, gsz = (nM - fm) < WGM ? (nM - fm) : WGM;
        u.pm = fm + ((wgid % nig) % gsz); u.pn = (wgid % nig) / gsz; return true;
    }
    __device__ __forceinline__ void a_ready(const Unit&) const {}
    __device__ __forceinline__ void done(const Unit&) const {}
};
__device__ __forceinline__ unsigned cvt_pk_bf16(float lo, float hi) { unsigned r; asm("v_cvt_pk_bf16_f32 %0, %1, %2" : "=v"(r) : "v"(lo), "v"(hi)); return r; }
template <class Epi, class Sched, bool STAMP = false>
__device__ __forceinline__ void gemm_phase(PG8_LAS unsigned char* lds, const Gemm g, const Sched& S, const Epi& E, unsigned long long* stamps) {
    const int tid = mk_tid(), wid = __builtin_amdgcn_readfirstlane(tid >> 6), lane = tid & 63, wr = wid >> 2, wc = wid & 3, fr = lane & 15, fq = lane >> 4;
    const int K = g.K, nt = K / BK;
    int ts_lo = 0, ts_hi = 0, nts = 0; const unsigned long long rt_entry = STAMP ? (unsigned long long)wall_clock64() : 0ull;
#define PG8_STAMP() do { if (STAMP && wid == 0 && nts < 64) { const unsigned long long _c = (unsigned long long)clock64(); \
        ts_lo = (lane == nts) ? (int)(unsigned)_c : ts_lo; ts_hi = (lane == nts) ? (int)(unsigned)(_c >> 32) : ts_hi; ++nts; } } while (0)
    PG8_STAMP();
    unsigned voffA[2], voffB[2];
#pragma unroll
    for (int i = 0; i < 2; ++i) { int R, C; stage_rc(tid * 16 + i * 8192, R, C); const int Rb = Epi::PERM ? ((R & ~31) + perm32(R & 31)) : R;
        voffA[i] = (unsigned)(R * K + C) * 2u; voffB[i] = (unsigned)(Rb * K + C) * 2u; }
    const size_t kstep = (size_t)(BK * 2);
    const size_t hstep = (size_t)HALF * K * 2;
    const size_t tstep = 2 * hstep;
    const size_t hstepB = g.bh ? g.bh : hstep, tstepB = g.bt ? g.bt : tstep;
    const unsigned ldsw = (unsigned)wid * 1024u;
    const int aoff = lds_byte(wr * 64 + fr, fq * 8), boff = lds_byte(wc * 32 + fr, fq * 8);
#define PG8_SA(b, h) (((b) * 2 + (h)) * HTB)
#define PG8_SB(b, h) ((4 + (b) * 2 + (h)) * HTB)
#define PG8_STAGE(bufoff, gbase, voff) do { _Pragma("unroll") for (int _i = 0; _i < 2; ++_i) \
        __builtin_amdgcn_global_load_lds((const unsigned*)((const char*)(gbase) + (voff)[_i]), (PG8_LAS unsigned*)(lds + (bufoff) + ldsw + _i * 8192), 16, 0, 0); } while (0)
#define PG8_LDA(dst, b, h) do { _Pragma("unroll") for (int m = 0; m < 4; ++m) _Pragma("unroll") for (int k = 0; k < 2; ++k) dst[m][k] = *(const PG8_LAS bf16x8*)(lds + PG8_SA(b, h) + aoff + m * 2048 + k * 1024); } while (0)
#define PG8_LDB(dst, b, h) do { _Pragma("unroll") for (int n = 0; n < 2; ++n) _Pragma("unroll") for (int k = 0; k < 2; ++k) dst[n][k] = *(const PG8_LAS bf16x8*)(lds + PG8_SB(b, h) + boff + n * 2048 + k * 1024); } while (0)
#define PG8_MMA(ai, bj, At, Bt) do { __builtin_amdgcn_s_setprio(1); _Pragma("unroll") for (int m = 0; m < 4; ++m) _Pragma("unroll") for (int n = 0; n < 2; ++n) _Pragma("unroll") for (int k = 0; k < 2; ++k) \
        acc[ai][bj][m][n] = __builtin_amdgcn_mfma_f32_16x16x32_bf16(Bt[n][k], At[m][k], acc[ai][bj][m][n], 0, 0, 0); __builtin_amdgcn_s_setprio(0); } while (0)
#define PG8_WAIT_V(n) asm volatile("s_waitcnt vmcnt(" #n ")" ::: "memory")
#define PG8_WAIT_L(n) asm volatile("s_waitcnt lgkmcnt(" #n ")" ::: "memory")
#define PG8_BAR __builtin_amdgcn_s_barrier()
#define PG8_SCHED __builtin_amdgcn_sched_barrier(0)
    Unit cur, nxt; int ui = 0;
    if (!S.next(0, cur)) return;
    f32x4 acc[2][2][4][2];
#pragma unroll
    for (int a = 0; a < 2; ++a)
#pragma unroll
        for (int b = 0; b < 2; ++b)
#pragma unroll
            for (int m = 0; m < 4; ++m)
#pragma unroll
                for (int n = 0; n < 2; ++n) acc[a][b][m][n] = (f32x4){0.f, 0.f, 0.f, 0.f};
    bf16x8 At[4][2], B0[2][2], B1[2][2];
    const char* cA = (const char*)g.A + (size_t)cur.pm * tstep; const char* cB = (const char*)g.Bt + (size_t)cur.pn * tstepB;
    S.a_ready(cur);
    E.pre(cur, wr, wc, fr, fq);
    E.commit();
    PG8_STAGE(PG8_SB(0, 0), cB, voffB); PG8_STAGE(PG8_SA(0, 0), cA, voffA); PG8_STAGE(PG8_SB(0, 1), cB + hstepB, voffB); PG8_STAGE(PG8_SA(0, 1), cA + hstep, voffA);
    if (wr == 1) PG8_BAR;
    PG8_WAIT_V(4); PG8_BAR;
    PG8_STAGE(PG8_SB(1, 0), cB + kstep, voffB); PG8_STAGE(PG8_SA(1, 0), cA + kstep, voffA); PG8_STAGE(PG8_SB(1, 1), cB + hstepB + kstep, voffB);
    PG8_WAIT_V(6); PG8_BAR;
    PG8_STAMP();
    for (;;) {
        const bool has_next = S.next(ui + 1, nxt);
        const char* nA = has_next ? (const char*)g.A + (size_t)nxt.pm * tstep : cA; const char* nB = has_next ? (const char*)g.Bt + (size_t)nxt.pn * tstepB : cB;
        for (int t = 0; t < nt; t += 2) {
            const bool last = (t == nt - 2);
            const char* a1 = cA + (size_t)(t + 1) * kstep;
            const char* a2 = last ? nA : cA + (size_t)(t + 2) * kstep; const char* b2 = last ? nB : cB + (size_t)(t + 2) * kstep;
            const char* a3 = a2 + kstep; const char* b3 = b2 + kstep;
            if (last && has_next) { S.a_ready(nxt); E.pre(nxt, wr, wc, fr, fq); }
            PG8_LDB(B0, 0, 0); PG8_SCHED; PG8_LDA(At, 0, 0); PG8_STAGE(PG8_SA(1, 1), a1 + hstep, voffA);
            PG8_WAIT_L(8); PG8_BAR; PG8_WAIT_L(0); PG8_MMA(0, 0, At, B0); PG8_BAR; PG8_SCHED;
            PG8_LDB(B1, 0, 1); PG8_STAGE(PG8_SB(0, 0), b2, voffB);
            PG8_BAR; PG8_WAIT_L(0); PG8_MMA(0, 1, At, B1); PG8_BAR;
            PG8_LDA(At, 0, 1); PG8_STAGE(PG8_SA(0, 0), a2, voffA);
            PG8_BAR; PG8_WAIT_L(0); PG8_MMA(1, 0, At, B0); PG8_BAR; PG8_SCHED;
            PG8_STAGE(PG8_SB(0, 1), b2 + hstepB, voffB);
            PG8_WAIT_V(6); PG8_BAR; PG8_MMA(1, 1, At, B1); PG8_BAR;
            PG8_LDB(B0, 1, 0); PG8_SCHED; PG8_LDA(At, 1, 0); PG8_STAGE(PG8_SA(0, 1), a2 + hstep, voffA);
            PG8_WAIT_L(8); PG8_BAR; PG8_WAIT_L(0); PG8_MMA(0, 0, At, B0); PG8_BAR; PG8_SCHED;
            PG8_LDB(B1, 1, 1); PG8_STAGE(PG8_SB(1, 0), b3, voffB);
            PG8_BAR; PG8_WAIT_L(0); PG8_MMA(0, 1, At, B1); PG8_BAR;
            PG8_LDA(At, 1, 1); PG8_STAGE(PG8_SA(1, 0), a3, voffA);
            PG8_BAR; PG8_WAIT_L(0); PG8_MMA(1, 0, At, B0); PG8_BAR; PG8_SCHED;
            PG8_STAGE(PG8_SB(1, 1), b3 + hstepB, voffB);
            PG8_WAIT_V(6); PG8_BAR; PG8_MMA(1, 1, At, B1); PG8_BAR;
        }
        PG8_STAMP();
        if constexpr (!Epi::AFTER_DRAIN) { E(acc, cur, wr, wc, fr, fq); E.commit(); S.done(cur); }
        PG8_STAMP();
        if (!has_next) break;
#pragma unroll
        for (int a = 0; a < 2; ++a)
#pragma unroll
            for (int b = 0; b < 2; ++b)
#pragma unroll
                for (int m = 0; m < 4; ++m)
#pragma unroll
                    for (int n = 0; n < 2; ++n) acc[a][b][m][n] = (f32x4){0.f, 0.f, 0.f, 0.f};
        cur = nxt; cA = nA; cB = nB; ++ui;
    }
    PG8_WAIT_V(0);
    if (wr == 0) PG8_BAR;
    PG8_BAR;
    if constexpr (Epi::AFTER_DRAIN) { E.fused(acc, cur, wr, wc, fr, fq, lds, wid, lane); S.done(cur); }
    PG8_STAMP();
    if (STAMP && wid == 0) { stamps[lane] = lane < nts ? (((unsigned long long)(unsigned)ts_hi << 32) | (unsigned)ts_lo) : 0ull;
        if (lane == 62) stamps[62] = rt_entry; if (lane == 63) stamps[63] = (unsigned long long)wall_clock64(); }
#undef PG8_STAMP
#undef PG8_SA
#undef PG8_SB
#undef PG8_STAGE
#undef PG8_LDA
#undef PG8_LDB
#undef PG8_MMA
#undef PG8_WAIT_V
#undef PG8_WAIT_L
#undef PG8_BAR
#undef PG8_SCHED
}
}
#define LAS __attribute__((address_space(3)))
#define XB_TMO      128
#define XB_XCNT(j)  (256  + 64 * (j))
#define XB_XSUB(j)  (1280 + 64 * (j))
#define XB_XGEN(j)  (2304 + 64 * (j))
#define XB_TOP      3328
#define XB_TOPGEN   3392
#define XCD_BAR_WORDS 3456
#define XB_SPIN_CAP (1u << 18)


__device__ __forceinline__ unsigned xb_ld(unsigned* p)              { return __hip_atomic_load(p, __ATOMIC_RELAXED, __HIP_MEMORY_SCOPE_AGENT); }
__device__ __forceinline__ unsigned xb_add(unsigned* p, unsigned v) { return __hip_atomic_fetch_add(p, v, __ATOMIC_RELAXED, __HIP_MEMORY_SCOPE_AGENT); }
__device__ __forceinline__ unsigned xb_xcc_id() { return (unsigned)__builtin_amdgcn_s_getreg((3 << 11) | 20) & 0xFu; }
#define XB_SPIN(cond, bar) do { unsigned _sp = 0; while (cond) { __builtin_amdgcn_s_sleep(1); \
    if ((++_sp & 255u) == 0u) { if (xb_ld(&(bar)[XB_TMO])) break; if (_sp > XB_SPIN_CAP) { atomicAdd(&(bar)[XB_TMO], 1u); break; } } } } while (0)

struct XcdBarrier {
    unsigned* bar; unsigned x;
    volatile LAS unsigned* st;
};

__device__ __forceinline__ XcdBarrier xcd_barrier_post(unsigned* bar, volatile LAS unsigned* st) {
    XcdBarrier b; b.bar = bar; b.x = xb_xcc_id(); b.st = st;
    if (mk_tid() == 0) (void)xb_add(&bar[XB_XCNT(b.x)], 1u);
    return b;
}
__device__ __forceinline__ void xcd_barrier_complete(unsigned* bar, unsigned x, unsigned& nloc, unsigned& nx) {
    const unsigned G = gridDim.x * gridDim.y * gridDim.z;
    unsigned sum, cnt, mine, sp = 0u;
    for (;;) {
        sum = 0u; cnt = 0u; mine = 0u;
#pragma unroll
        for (unsigned j = 0; j < 16; ++j) { const unsigned c = xb_ld(&bar[XB_XCNT(j)]); sum += c; cnt += (c > 0u) ? 1u : 0u; mine = (j == x) ? c : mine; }
        if (sum == G) break;
        __builtin_amdgcn_s_sleep(1);
        if ((++sp & 255u) == 0u) { if (xb_ld(&bar[XB_TMO])) break; if (sp > XB_SPIN_CAP) { atomicAdd(&bar[XB_TMO], 1u); break; } }
    }
    nloc = mine > 0u ? mine : 1u; nx = cnt > 0u ? cnt : 1u;
}

__device__ __forceinline__ void xcd_barrier(const XcdBarrier& b) {
    asm volatile("s_waitcnt vmcnt(0)" ::: "memory");
    __syncthreads();
    if (mk_tid() == 0) {
        unsigned* bar = b.bar;
        __builtin_amdgcn_s_waitcnt(0);
        unsigned nloc = b.st[0], nx = b.st[1];
        if (nloc == 0u) { xcd_barrier_complete(bar, b.x, nloc, nx); b.st[0] = nloc; b.st[1] = nx; }
        const unsigned old = xb_add(&bar[XB_XSUB(b.x)], 1u);
        const unsigned gen = old / nloc;
        if (old + 1u == (gen + 1u) * nloc) {
            __builtin_amdgcn_fence(__ATOMIC_RELEASE, "agent");
            asm volatile("s_waitcnt vmcnt(0)" ::: "memory");
            const unsigned og = xb_add(&bar[XB_TOP], 1u);
            const unsigned tg = og / nx;
            if (og + 1u == (tg + 1u) * nx) xb_add(&bar[XB_TOPGEN], 1u);
            else XB_SPIN(xb_ld(&bar[XB_TOPGEN]) == tg, bar);
            __builtin_amdgcn_fence(__ATOMIC_ACQUIRE, "agent");
            xb_add(&bar[XB_XGEN(b.x)], 1u);
            asm volatile("s_waitcnt vmcnt(0)" ::: "memory");
        } else {
            XB_SPIN(xb_ld(&bar[XB_XGEN(b.x)]) == gen, bar);
            __builtin_amdgcn_fence(__ATOMIC_ACQUIRE, "agent");
            asm volatile("s_waitcnt vmcnt(0)" ::: "memory");
        }
    }
    __syncthreads();
}

typedef unsigned short bf16_t;
typedef short bf16x8 __attribute__((ext_vector_type(8)));
typedef float f32x4 __attribute__((ext_vector_type(4)));
typedef float f32x16 __attribute__((ext_vector_type(16)));
typedef unsigned u32x4 __attribute__((ext_vector_type(4)));
typedef unsigned u32x2 __attribute__((ext_vector_type(2)));


constexpr int DM = 1024, NCOL = 3584, DFF = 2816, NFF = 5632;
constexpr int GT = 16384;
constexpr int NGROUP = 4, DEPTH = 2;
constexpr int NTHR = 512;
constexpr int LDS_BYTES = 131072 + 16 + 8192;
constexpr int LDS_CTW_OFF = 131072 + 16;
constexpr int LDS_BAR_OFF = 131072;
constexpr float EPS = 1e-6f;
constexpr int C_Q = 0, C_FF = 512, C_FB = 1024, C_I = 1536, C_G = 2048, C_U = 2560, C_V = 3072;

constexpr size_t SZ_WIN = (size_t)NCOL * DM * 2, SZ_WOUT = (size_t)DM * DM * 2, SZ_WFI = (size_t)NFF * DM * 2, SZ_WFO = (size_t)DM * DFF * 2;
constexpr size_t WS_WIN = 0;
constexpr size_t WS_WOUT = WS_WIN + 2 * SZ_WIN;
constexpr size_t WS_WFI = WS_WOUT + 2 * SZ_WOUT;
constexpr size_t WS_WFO = WS_WFI + 2 * SZ_WFI;
constexpr size_t WS_XB = WS_WFO + 2 * SZ_WFO;
constexpr int PT = 2 * GT;
constexpr size_t WS_PROJ = WS_XB + (size_t)NGROUP * GT * DM * 2;
constexpr size_t WS_ACT = WS_PROJ;
constexpr size_t WS_HB = WS_PROJ + (size_t)PT * DFF * 2;
static_assert((size_t)PT * DFF * 2 + (size_t)512 * 4 * NFF * 2 <= (size_t)PT * NCOL * 2, "act + halo alias proj");
constexpr size_t WS_MIX = WS_PROJ + (size_t)PT * NCOL * 2;
constexpr size_t OUT_US = 0;
constexpr size_t OUT_D = OUT_US + (size_t)512 * 8 * 16384 * 2;
static_assert(OUT_D + (size_t)512 * 8 * 128 * 4 <= (size_t)NGROUP * GT * DM * 4, "states fit the output buffer");
constexpr size_t WS_SS1 = WS_MIX + (size_t)PT * DM * 2;
constexpr size_t WS_SS2 = WS_SS1 + (size_t)NGROUP * GT * 8;
constexpr size_t WS_CT = WS_SS2 + (size_t)PT * 8;
constexpr size_t WS_BAR = WS_CT + (size_t)DEPTH * DFF * 8 * 4;
constexpr size_t WS_TS = WS_BAR + 16384;
constexpr size_t WS_END = WS_TS + 4096;

struct Params {
    const float* x_prompt; const float* x_sample; const float* norm1_g; const float* w_in; const float* lb_logits; const float* hg_norm_g;
    const float* sg_norm_g; const float* sg_norm_b; const float* sg_w; const float* sg_b; const float* w_out; const float* norm2_g;
    const float* w_ffn_in; const float* conv_w; const float* conv_b; const float* w_ffn_out; const float* final_g;
    float* out; unsigned char* ws; int ph_lo, ph_hi;
};

typedef __bf16 bf16x2_t __attribute__((ext_vector_type(2)));
typedef float f32x2_t __attribute__((ext_vector_type(2)));
__device__ __forceinline__ unsigned pk2(float lo, float hi) { f32x2_t v = {lo, hi}; bf16x2_t b = __builtin_convertvector(v, bf16x2_t); return __builtin_bit_cast(unsigned, b); }
__device__ __forceinline__ float bf2f(unsigned short b) { return __uint_as_float(((unsigned)b) << 16); }
__device__ __forceinline__ float bflo(unsigned w) { return __uint_as_float(w << 16); }
__device__ __forceinline__ float bfhi(unsigned w) { return __uint_as_float(w & 0xffff0000u); }
__device__ __forceinline__ float fast_exp(float x) { return __expf(x); }
__device__ __forceinline__ float gelu_t(float x) { const float y = 1.5957691216f * (x + 0.044715f * x * x * x); return x * __builtin_amdgcn_rcpf(1.0f + __expf(-y)); }
__device__ __forceinline__ float silu_f(float x) { return x * __builtin_amdgcn_rcpf(1.0f + __expf(-x)); }
__device__ __forceinline__ float wave_sum(float v) {
#pragma unroll
    for (int o = 32; o > 0; o >>= 1) v += __shfl_xor(v, o, 64);
    return v;
}

__device__ __forceinline__ void lds_barrier() { asm volatile("s_waitcnt lgkmcnt(0)\n\ts_barrier" ::: "memory"); }

typedef unsigned long long u64;
__device__ __forceinline__ u64 ss_fix(float v) { return (u64)(v * 16777216.0f + 0.5f); }
__device__ __forceinline__ float ss_rstd(u64 q) { return rsqrtf((float)q * (1.0f / 16777216.0f) * (1.0f / DM) + EPS); }
struct EpiB16 {
    static constexpr bool PERM = true, AFTER_DRAIN = false;
    bf16_t* O; int ldc; const u64* SS;
    mutable u64 cq[2];
    __device__ __forceinline__ void commit() const { cq[0] = pq[0]; cq[1] = pq[1]; }
    mutable u64 pq[2];
    __device__ __forceinline__ void pre(const pg8::Unit& u, int wr, int wc, int fr, int fq) const {
        const int r = u.pm * 256 + wr * 64 + fq * 16 + fr;
        pq[0] = SS[r]; pq[1] = SS[r + 128];
    }
    __device__ __forceinline__ void operator()(const f32x4 (&acc)[2][2][4][2], const pg8::Unit& u, int wr, int wc, int fr, int fq) const {
        const int row0 = u.pm * 256 + wr * 64 + fr, col0 = u.pn * 256 + wc * 32 + 8 * fq;
        float rsv[2][4];
#pragma unroll
        for (int ai = 0; ai < 2; ++ai) {
            const float own = ss_rstd(cq[ai]);
#pragma unroll
            for (int m = 0; m < 4; ++m) rsv[ai][m] = __shfl(own, fr + 16 * m, 64);
        }
#pragma unroll
        for (int ai = 0; ai < 2; ++ai)
#pragma unroll
            for (int m = 0; m < 4; ++m) {
                const int row = row0 + ai * 128 + m * 16;
                const float rs = rsv[ai][m];
                bf16_t* rowp = O + (size_t)row * ldc + col0;
#pragma unroll
                for (int bj = 0; bj < 2; ++bj) {
                    const f32x4 v0 = acc[ai][bj][m][0] * rs, v1 = acc[ai][bj][m][1] * rs;
                    u32x4 o; o[0] = pk2(v0[0], v0[1]); o[1] = pk2(v0[2], v0[3]); o[2] = pk2(v1[0], v1[1]); o[3] = pk2(v1[2], v1[3]);
                    *(u32x4*)(rowp + bj * 128) = o;
                }
            }
    }
};
struct EpiRes {
    static constexpr bool PERM = true, AFTER_DRAIN = false;
    bf16_t* X; u64* SS;
    __device__ __forceinline__ void pre(const pg8::Unit&, int, int, int, int) const {}
    __device__ __forceinline__ void commit() const {}
    __device__ __forceinline__ void operator()(const f32x4 (&acc)[2][2][4][2], const pg8::Unit& u, int wr, int wc, int fr, int fq) const {
        const int row0 = u.pm * 256 + wr * 64 + fr, col0 = u.pn * 256 + wc * 32 + 8 * fq;
#pragma unroll
        for (int ai = 0; ai < 2; ++ai) {
            u32x4 xall[4][2];
#pragma unroll
            for (int m = 0; m < 4; ++m)
#pragma unroll
                for (int bj = 0; bj < 2; ++bj) xall[m][bj] = *(const u32x4*)(X + (size_t)(row0 + ai * 128 + m * 16) * DM + col0 + bj * 128);
#pragma unroll
            for (int m = 0; m < 4; ++m) {
                const int row = row0 + ai * 128 + m * 16;
                bf16_t* rowp = X + (size_t)row * DM + col0;
                u32x4 xin[2];
#pragma unroll
                for (int bj = 0; bj < 2; ++bj) xin[bj] = xall[m][bj];
                float ss = 0.f;
#pragma unroll
                for (int bj = 0; bj < 2; ++bj) {
                    const f32x4 v0 = acc[ai][bj][m][0], v1 = acc[ai][bj][m][1];
                    u32x4 o;
                    o[0] = pk2(bflo(xin[bj][0]) + v0[0], bfhi(xin[bj][0]) + v0[1]); o[1] = pk2(bflo(xin[bj][1]) + v0[2], bfhi(xin[bj][1]) + v0[3]);
                    o[2] = pk2(bflo(xin[bj][2]) + v1[0], bfhi(xin[bj][2]) + v1[1]); o[3] = pk2(bflo(xin[bj][3]) + v1[2], bfhi(xin[bj][3]) + v1[3]);
#pragma unroll
                    for (int e = 0; e < 4; ++e) { const float a = bflo(o[e]), b = bfhi(o[e]); ss += a * a + b * b; }
                    *(u32x4*)(rowp + bj * 128) = o;
                }
                ss += __shfl_xor(ss, 16, 64); ss += __shfl_xor(ss, 32, 64);
                if (fq == 0) atomicAdd(SS + row, ss_fix(ss));
            }
        }
    }
};

__device__ __forceinline__ float dpp_ror1(float v) { return __builtin_bit_cast(float, __builtin_amdgcn_mov_dpp(__builtin_bit_cast(int, v), 0x121, 0xF, 0xF, false)); }
__device__ __forceinline__ float dpp_ror15(float v) { return __builtin_bit_cast(float, __builtin_amdgcn_mov_dpp(__builtin_bit_cast(int, v), 0x12F, 0xF, 0xF, false)); }
__device__ __forceinline__ void conv4(const float (&v)[4], float w0, float w1, float w2, float b, int fr, bool r1prev, float (&o)[4]) {
    float P[4], N[4];
#pragma unroll
    for (int m = 0; m < 4; ++m) { P[m] = dpp_ror1(v[m]); N[m] = dpp_ror15(v[m]); }
#pragma unroll
    for (int m = 0; m < 4; ++m) {
        const float prev = fr > 0 ? P[m] : (m > 0 ? P[m - 1] : 0.f), next = fr < 15 ? N[m] : (m < 3 ? N[m + 1] : 0.f);
        o[m] = w0 * prev + w1 * v[m] + w2 * next + b;
    }
}
typedef _Float16 h2 __attribute__((ext_vector_type(2)));
__device__ __forceinline__ h2 pkh(float a, float b) { return __builtin_bit_cast(h2, __builtin_amdgcn_cvt_pkrtz(a, b)); }
__device__ __forceinline__ h2 dpp_h2(h2 v, const int ctrl_is_ror15) {
    const int i = __builtin_bit_cast(int, v);
    return __builtin_bit_cast(h2, ctrl_is_ror15 ? __builtin_amdgcn_mov_dpp(i, 0x12F, 0xF, 0xF, false) : __builtin_amdgcn_mov_dpp(i, 0x121, 0xF, 0xF, false));
}
__device__ __forceinline__ h2 sel_h2(bool c, h2 a, h2 b) { const int ia = __builtin_bit_cast(int, a), ib = __builtin_bit_cast(int, b); return __builtin_bit_cast(h2, c ? ia : ib); }
__device__ __forceinline__ void conv4h(const h2 (&v)[4], h2 w0, h2 w1, h2 w2, h2 b, int fr, h2 (&o)[4]) {
    h2 P[4], N[4];
#pragma unroll
    for (int m = 0; m < 4; ++m) { P[m] = dpp_h2(v[m], 0); N[m] = dpp_h2(v[m], 1); }
    const h2 z = {(_Float16)0.f, (_Float16)0.f};
#pragma unroll
    for (int m = 0; m < 4; ++m) {
        const h2 prev = sel_h2(fr > 0, P[m], m > 0 ? P[m - 1] : z), next = sel_h2(fr < 15, N[m], m < 3 ? N[m + 1] : z);
        o[m] = w0 * prev + w1 * v[m] + w2 * next + b;
    }
}
struct EpiConv {
    static constexpr bool PERM = true, AFTER_DRAIN = false;
    bf16_t* ACT; bf16_t* HB; const u64* SS; const float* CT;
    LAS float* CTW;
    mutable u64 cq[2]; mutable f32x4 cct;
    __device__ __forceinline__ void commit() const { cq[0] = pq[0]; cq[1] = pq[1]; cct = pct; }
    mutable u64 pq[2]; mutable f32x4 pct;
    __device__ __forceinline__ void pre(const pg8::Unit& u, int wr, int wc, int fr, int fq) const {
        const int r = u.pm * 256 + wr * 64 + fq * 16 + fr;
        pq[0] = SS[r]; pq[1] = SS[r + 128];
        pct = *(const f32x4*)(CT + (size_t)(u.pn * 128 + wc * 32) * 8 + (fq * 16 + fr) * 4);
    }
    __device__ __forceinline__ void operator()(const f32x4 (&acc)[2][2][4][2], const pg8::Unit& u, int wr, int wc, int fr, int fq) const {
        asm volatile("" : "+v"(fr), "+v"(fq), "+s"(wr), "+s"(wc));
        const int row0 = u.pm * 256 + wr * 64 + fr, ch0 = u.pn * 128 + wc * 32 + 8 * fq;
        const bool r1prev = __builtin_amdgcn_mov_dpp(fr, 0x121, 0xF, 0xF, false) == ((fr + 15) & 15);
        LAS float* ctw = CTW + (wr * 4 + wc) * 256;
        *(LAS f32x4*)(ctw + (fq * 16 + fr) * 4) = cct;
        float rsa[2][4];
#pragma unroll
        for (int ai = 0; ai < 2; ++ai) {
            const float own = ss_rstd(cq[ai]);
#pragma unroll
            for (int m = 0; m < 4; ++m) rsa[ai][m] = __shfl(own, fr + 16 * m, 64);
        }
#pragma unroll
        for (int ai = 0; ai < 2; ++ai) {
            __builtin_amdgcn_sched_barrier(0);
            float rs[4];
#pragma unroll
            for (int m = 0; m < 4; ++m) rs[m] = rsa[ai][m];
            const int blk = u.pm * 4 + ai * 2 + wr;
#pragma unroll
            for (int n = 0; n < 2; ++n) {
                __builtin_amdgcn_sched_barrier(0);
                const int ch = ch0 + 4 * n;
                const LAS float* ct = ctw + (8 * fq + 4 * n) * 8;
                unsigned pk0[4];
#pragma unroll
                for (int ep = 0; ep < 2; ++ep) {
                    const int e = ep * 2;
                    const f32x4 wga = *(const LAS f32x4*)(ct + e * 8), wua = *(const LAS f32x4*)(ct + e * 8 + 4), wgb = *(const LAS f32x4*)(ct + e * 8 + 8), wub = *(const LAS f32x4*)(ct + e * 8 + 12);
                    h2 x[4], og[4], ou[4];
#pragma unroll
                    for (int m = 0; m < 4; ++m) x[m] = pkh(acc[ai][0][m][n][e] * rs[m], acc[ai][0][m][n][e + 1] * rs[m]);
                    conv4h(x, pkh(wga[0], wgb[0]), pkh(wga[1], wgb[1]), pkh(wga[2], wgb[2]), pkh(wga[3], wgb[3]), fr, og);
                    __builtin_amdgcn_sched_barrier(0);
#pragma unroll
                    for (int m = 0; m < 4; ++m) x[m] = pkh(acc[ai][1][m][n][e] * rs[m], acc[ai][1][m][n][e + 1] * rs[m]);
                    conv4h(x, pkh(wua[0], wub[0]), pkh(wua[1], wub[1]), pkh(wua[2], wub[2]), pkh(wua[3], wub[3]), fr, ou);
#pragma unroll
                    for (int m = 0; m < 4; ++m) {
                        const float g0 = (float)og[m][0], g1 = (float)og[m][1];
                        const float a0 = g0 * __builtin_amdgcn_rcpf(1.0f + __expf(-g0)) * (float)ou[m][0], a1 = g1 * __builtin_amdgcn_rcpf(1.0f + __expf(-g1)) * (float)ou[m][1];
                        const bool deferred = (m == 0 && fr == 0) || (m == 3 && fr == 15);
                        if (ep == 0) pk0[m] = pk2(a0, a1);
                        else if (!deferred) { u32x2 o; o[0] = pk0[m]; o[1] = pk2(a0, a1); *(u32x2*)(ACT + (size_t)(row0 + ai * 128 + m * 16) * DFF + ch) = o; }
                    }
                    __builtin_amdgcn_sched_barrier(0);
                }
                if (fr < 2) {
                    bf16_t* hp = HB + (size_t)(blk * 4 + fr) * NFF + ch;
                    const f32x4 a = acc[ai][0][0][n] * rs[0], b = acc[ai][1][0][n] * rs[0];
                    u32x2 o; o[0] = pk2(a[0], a[1]); o[1] = pk2(a[2], a[3]); *(u32x2*)hp = o;
                    o[0] = pk2(b[0], b[1]); o[1] = pk2(b[2], b[3]); *(u32x2*)(hp + DFF) = o;
                }
                if (fr >= 14) {
                    bf16_t* hp = HB + (size_t)(blk * 4 + fr - 12) * NFF + ch;
                    const f32x4 a = acc[ai][0][3][n] * rs[3], b = acc[ai][1][3][n] * rs[3];
                    u32x2 o; o[0] = pk2(a[0], a[1]); o[1] = pk2(a[2], a[3]); *(u32x2*)hp = o;
                    o[0] = pk2(b[0], b[1]); o[1] = pk2(b[2], b[3]); *(u32x2*)(hp + DFF) = o;
                }
            }
        }
    }
};

__device__ __forceinline__ void transpose_convert(LAS unsigned char* lds, const float* src, bf16_t* dst, int K, int N, int tile0, int tstride, const float* kscale) {
    LAS float* T = (LAS float*)lds;
    const int tid = mk_tid();
    const int ntn = N / 64, ntk = K / 64, ntiles = ntn * ntk;
    for (int t = tile0; t < ntiles; t += tstride) {
        const int tk = t / ntn, tn = t % ntn;
        {
            const int r = tid >> 3, c = (tid & 7) * 8;
            const float* s = src + (size_t)(tk * 64 + r) * N + tn * 64 + c;
            f32x4 a = *(const f32x4*)s, b = *(const f32x4*)(s + 4);
            if (kscale) { const float ks = kscale[tk * 64 + r]; a = a * ks; b = b * ks; }
            LAS float* d = T + r * 65 + c;
            d[0] = a[0]; d[1] = a[1]; d[2] = a[2]; d[3] = a[3]; d[4] = b[0]; d[5] = b[1]; d[6] = b[2]; d[7] = b[3];
        }
        lds_barrier();
        {
            const int n = tid >> 3, k0 = (tid & 7) * 8;
            float v[8];
#pragma unroll
            for (int j = 0; j < 8; ++j) v[j] = T[(k0 + j) * 65 + n];
            u32x4 o; o[0] = pk2(v[0], v[1]); o[1] = pk2(v[2], v[3]); o[2] = pk2(v[4], v[5]); o[3] = pk2(v[6], v[7]);
            *(u32x4*)(dst + (size_t)(tn * 64 + n) * K + tk * 64 + k0) = o;
        }
        lds_barrier();
    }
}

__device__ __forceinline__ void prepass_rows(const float* src, bf16_t* xb, u64* SS, int rows) {
    const int lane = mk_tid() & 63, wave = mk_tid() >> 6;
    for (int row = mk_bid() * 8 + wave; row < rows; row += gridDim.x * 8) {
        const float* s = src + (size_t)row * DM;
        f32x4 v[4];
#pragma unroll
        for (int i = 0; i < 4; ++i) v[i] = *(const f32x4*)(s + lane * 4 + i * 256);
        float ss = 0.f;
#pragma unroll
        for (int i = 0; i < 4; ++i) {
            u32x2 o; o[0] = pk2(v[i][0], v[i][1]); o[1] = pk2(v[i][2], v[i][3]);
            const float a = bflo(o[0]), b = bfhi(o[0]), c = bflo(o[1]), d = bfhi(o[1]);
            ss += a * a + b * b + c * c + d * d;
            *(u32x2*)(xb + (size_t)row * DM + lane * 4 + i * 256) = o;
        }
        ss = wave_sum(ss);
        if (lane == 0) SS[row] = ss_fix(ss);
    }
}
__device__ __forceinline__ void final_rows(const bf16_t* xb, const u64* SS, const float* gam, float* out, int rows) {
    const int lane = mk_tid() & 63, wave = mk_tid() >> 6;
    f32x4 gv[4];
#pragma unroll
    for (int i = 0; i < 4; ++i) gv[i] = *(const f32x4*)(gam + lane * 4 + i * 256);
    for (int row = mk_bid() * 8 + wave; row < rows; row += gridDim.x * 8) {
        const float rstd = ss_rstd(SS[row]);
        u32x2 w[4];
#pragma unroll
        for (int i = 0; i < 4; ++i) w[i] = *(const u32x2*)(xb + (size_t)row * DM + lane * 4 + i * 256);
#pragma unroll
        for (int i = 0; i < 4; ++i) {
            f32x4 y; y[0] = bflo(w[i][0]); y[1] = bfhi(w[i][0]); y[2] = bflo(w[i][1]); y[3] = bfhi(w[i][1]);
            y = y * rstd * gv[i];
            *(f32x4*)(out + (size_t)row * DM + lane * 4 + i * 256) = y;
        }
    }
}

__device__ __forceinline__ bf16x8 lds_frag(const LAS bf16_t* base, int row, int ld, int k) { return *(const LAS bf16x8*)(base + row * ld + k); }

constexpr int NAT_LD = 136, T64_LD = 72;
__device__ __forceinline__ float frcp(float x) { return __builtin_amdgcn_rcpf(x); }
struct Tile2 { u32x4 a, b; };
__device__ __forceinline__ Tile2 ld_tile(const bf16_t* g, int tid) {
    const int r = tid >> 3, c = (tid & 7) * 16; Tile2 t;
    t.a = *(const u32x4*)(g + (size_t)r * NCOL + c); t.b = *(const u32x4*)(g + (size_t)r * NCOL + c + 8); return t;
}
__device__ __forceinline__ void st_tile(LAS bf16_t* NAT, const Tile2& t, int tid) {
    const int r = tid >> 3, c = (tid & 7) * 16;
    *(LAS u32x4*)(NAT + r * NAT_LD + c) = t.a; *(LAS u32x4*)(NAT + r * NAT_LD + c + 8) = t.b;
}
__device__ __forceinline__ float fexp2(float x) { return __builtin_amdgcn_exp2f(x); }
__device__ __forceinline__ void gate16(const LAS bf16_t* NAT, int c, int seg, float lb, int dir, float (&b)[16], float (&kk)[16], float& tot) {
    float lf[16];
    const float olb = 1.0f - lb;
#pragma unroll
    for (int j = 0; j < 16; ++j) {
        const float z = bf2f(NAT[(seg * 16 + j) * NAT_LD + c]);
        const float e = fexp2(-1.44269504f * fabsf(z)), s = frcp(1.0f + e), es = e * s;
        const float sig = z >= 0.f ? s : es, nsig = z >= 0.f ? es : s;
        lf[j] = __builtin_amdgcn_logf(lb + olb * sig);
        kk[j] = olb * nsig;
    }
    if (dir == 0) { float a = 0.f;
#pragma unroll
        for (int j = 0; j < 16; ++j) { a += lf[j]; b[j] = a; } tot = a; }
    else { float a = 0.f;
#pragma unroll
        for (int j = 15; j >= 0; --j) { a += lf[j]; b[j] = a; } tot = a; }
}
__device__ __forceinline__ float lb_value(const Params& p, int l, int dir, int ch) {
    if (l == 0) return 0.f;
    const float l0 = p.lb_logits[(dir * 2 + 0) * 512 + ch], l1 = p.lb_logits[(dir * 2 + 1) * 512 + ch];
    return 1.0f / (1.0f + __expf(l0 - l1));
}
__device__ __forceinline__ void build_vt(const LAS bf16_t* NAT, LAS bf16_t* VT, int c, int seg) {
    unsigned w[8];
#pragma unroll
    for (int j = 0; j < 8; ++j) w[j] = (unsigned)NAT[(seg * 16 + 2 * j) * NAT_LD + c] | ((unsigned)NAT[(seg * 16 + 2 * j + 1) * NAT_LD + c] << 16);
    u32x4 a, b; a[0] = w[0]; a[1] = w[1]; a[2] = w[2]; a[3] = w[3]; b[0] = w[4]; b[1] = w[5]; b[2] = w[6]; b[3] = w[7];
    *(LAS u32x4*)(VT + c * T64_LD + seg * 16) = a; *(LAS u32x4*)(VT + c * T64_LD + seg * 16 + 8) = b;
}

constexpr int A_NV = 0, A_NZ0 = 17408, A_NZ1 = 34816, A_VT = 52224, A_KT0 = 70656, A_KT1 = 89088, A_TOT = 107520;
static_assert(A_TOT + 4096 <= 131072, "lds");
__device__ void hgrn_states(LAS unsigned char* lds, const Params& p, int l, const bf16_t* proj, bf16_t* US, float* Dd, const int NI) {
    LAS bf16_t* NV = (LAS bf16_t*)(lds + A_NV); LAS bf16_t* VT = (LAS bf16_t*)(lds + A_VT);
    LAS float* TOT = (LAS float*)(lds + A_TOT);
    const int tid = mk_tid(), lane = tid & 63, wave = tid >> 6, c = tid & 127, seg = tid >> 7;
    const int G = gridDim.x;
    int item = mk_bid();
    Tile2 tv, tz0, tz1;
    if (item < NI) { const bf16_t* base = proj + (size_t)(item >> 2) * 64 * NCOL + (item & 3) * 128; tv = ld_tile(base + C_I, tid); tz0 = ld_tile(base + C_FF, tid); tz1 = ld_tile(base + C_FB, tid); }
    int hcur = -1; float lbv[2] = {0.f, 0.f};
    for (; item < NI; item += G) {
        const int h = item & 3;
        if (h != hcur) { hcur = h; lbv[0] = lb_value(p, l, 0, h * 128 + c); lbv[1] = lb_value(p, l, 1, h * 128 + c); }
        st_tile(NV, tv, tid); st_tile((LAS bf16_t*)(lds + A_NZ0), tz0, tid); st_tile((LAS bf16_t*)(lds + A_NZ1), tz1, tid);
        { const int ni = item + G; if (ni < NI) { const bf16_t* base = proj + (size_t)(ni >> 2) * 64 * NCOL + (ni & 3) * 128; tv = ld_tile(base + C_I, tid); tz0 = ld_tile(base + C_FF, tid); tz1 = ld_tile(base + C_FB, tid); } }
        lds_barrier();
        build_vt(NV, VT, c, seg);
        float b[2][16], kk[2][16];
#pragma unroll
        for (int dir = 0; dir < 2; ++dir) {
            float tot; gate16((const LAS bf16_t*)(lds + (dir ? A_NZ1 : A_NZ0)), c, seg, lbv[dir], dir, b[dir], kk[dir], tot);
            TOT[(dir * 4 + seg) * 128 + c] = tot;
        }
        lds_barrier();
#pragma unroll
        for (int dir = 0; dir < 2; ++dir) {
            float off = 0.f, total = 0.f;
#pragma unroll
            for (int s = 0; s < 4; ++s) { const float t = TOT[(dir * 4 + s) * 128 + c]; total += t; if (dir == 0 ? (s < seg) : (s > seg)) off += t; }
            unsigned w[8];
#pragma unroll
            for (int j = 0; j < 8; ++j) {
                const float k0 = kk[dir][2 * j] * fexp2(total - (b[dir][2 * j] + off)), k1 = kk[dir][2 * j + 1] * fexp2(total - (b[dir][2 * j + 1] + off));
                w[j] = pk2(k0, k1);
            }
            u32x4 a, bb; a[0] = w[0]; a[1] = w[1]; a[2] = w[2]; a[3] = w[3]; bb[0] = w[4]; bb[1] = w[5]; bb[2] = w[6]; bb[3] = w[7];
            LAS bf16_t* KT = (LAS bf16_t*)(lds + (dir ? A_KT1 : A_KT0));
            *(LAS u32x4*)(KT + c * T64_LD + seg * 16) = a; *(LAS u32x4*)(KT + c * T64_LD + seg * 16 + 8) = bb;
            if (seg == 0) Dd[(size_t)(item * 2 + dir) * 128 + c] = fexp2(total);
        }
        lds_barrier();
        const int mb = wave & 3, nh = wave >> 2, lr = lane & 31, lh = lane >> 5;
#pragma unroll
        for (int dir = 0; dir < 2; ++dir) {
            const LAS bf16_t* KT = (const LAS bf16_t*)(lds + (dir ? A_KT1 : A_KT0));
            f32x16 acc0 = {}, acc1 = {};
#pragma unroll
            for (int ks = 0; ks < 4; ++ks) {
                const bf16x8 af = lds_frag(KT, mb * 32 + lr, T64_LD, ks * 16 + lh * 8);
                const bf16x8 b0 = lds_frag(VT, nh * 64 + lr, T64_LD, ks * 16 + lh * 8);
                const bf16x8 b1 = lds_frag(VT, nh * 64 + 32 + lr, T64_LD, ks * 16 + lh * 8);
                acc0 = __builtin_amdgcn_mfma_f32_32x32x16_bf16(af, b0, acc0, 0, 0, 0);
                acc1 = __builtin_amdgcn_mfma_f32_32x32x16_bf16(af, b1, acc1, 0, 0, 0);
            }
            bf16_t* Ub = US + (size_t)(item * 2 + dir) * 16384;
#pragma unroll
            for (int i = 0; i < 4; ++i) {
                const int k = mb * 32 + 8 * i + 4 * lh;
                u32x2 o0, o1; o0[0] = pk2(acc0[4 * i], acc0[4 * i + 1]); o0[1] = pk2(acc0[4 * i + 2], acc0[4 * i + 3]);
                o1[0] = pk2(acc1[4 * i], acc1[4 * i + 1]); o1[1] = pk2(acc1[4 * i + 2], acc1[4 * i + 3]);
                *(u32x2*)(Ub + (size_t)(nh * 64 + lr) * 128 + k) = o0;
                *(u32x2*)(Ub + (size_t)(nh * 64 + 32 + lr) * 128 + k) = o1;
            }
        }
    }
    lds_barrier();
}

__device__ void hgrn_scan(int pr, bf16_t* US, const float* Dd) {
    const int NC = pr == 0 ? 64 : 256, NSEQ = pr == 0 ? 8 : 2;
    const int nitems = NSEQ * 8 * 8192;
    for (int item = mk_bid() * NTHR + mk_tid(); item < nitems; item += gridDim.x * NTHR) {
        const int e2 = item & 8191, sq = item >> 13, dir = sq & 1, h = (sq >> 1) & 3, s = sq >> 3;
        const int k = (e2 * 2) & 127;
        float s0 = 0.f, s1 = 0.f;
        const int n0 = dir == 0 ? 0 : NC - 1, dn = dir == 0 ? 1 : -1;
        for (int nb = 0; nb < NC; nb += 32) {
            unsigned u[32]; float d0[32], d1[32];
#pragma unroll
            for (int j = 0; j < 32; ++j) {
                const int n = n0 + dn * (nb + j);
                const size_t sidx = ((size_t)(s * NC + n) * 4 + h) * 2 + dir;
                u[j] = *(const unsigned*)(US + sidx * 16384 + e2 * 2);
                const float2 dd = *(const float2*)(Dd + sidx * 128 + k);
                d0[j] = dd.x; d1[j] = dd.y;
            }
#pragma unroll
            for (int j = 0; j < 32; ++j) {
                const int n = n0 + dn * (nb + j);
                const size_t sidx = ((size_t)(s * NC + n) * 4 + h) * 2 + dir;
                *(unsigned*)(US + sidx * 16384 + e2 * 2) = pk2(s0, s1);
                s0 = d0[j] * s0 + bflo(u[j]); s1 = d1[j] * s1 + bfhi(u[j]);
            }
        }
    }
}

constexpr int C_NQ = 0, C_NV = 17408, C_NZ0 = 34816, C_NZ1 = 52224, C_VT = 69632, C_PS = 88064, C_TOT = 97280;
constexpr int C_QS = C_NQ, C_KS = C_NV, C_QI = C_NZ0, C_OL = 0;
static_assert(C_TOT + 4096 <= 131072, "lds");
__device__ __forceinline__ unsigned pair_sel(int odd) {
    const bool F = __builtin_amdgcn_perm(0x03020100u, 0x13121110u, 0x03020100u) == 0x03020100u;
    const unsigned o0 = F ? 0u : 4u, x0 = F ? 4u : 0u;
    const unsigned s_even = (o0 + 0) | ((o0 + 1) << 8) | ((x0 + 0) << 16) | ((x0 + 1) << 24);
    const unsigned s_odd = (x0 + 2) | ((x0 + 3) << 8) | ((o0 + 2) << 16) | ((o0 + 3) << 24);
    return odd ? s_odd : s_even;
}
__device__ __forceinline__ unsigned pair_word(unsigned own, unsigned sel) {
    const unsigned other = (unsigned)__builtin_amdgcn_mov_dpp((int)own, 0xB1, 0xF, 0xF, false);
    return __builtin_amdgcn_perm(own, other, sel);
}
__device__ void hgrn_out(LAS unsigned char* lds, const Params& p, int l, const bf16_t* proj, const bf16_t* US, bf16_t* mix, const int NI) {
    LAS bf16_t* VT = (LAS bf16_t*)(lds + C_VT); LAS float* TOT = (LAS float*)(lds + C_TOT);
    LAS bf16_t* QS = (LAS bf16_t*)(lds + C_QS); LAS bf16_t* KS = (LAS bf16_t*)(lds + C_KS); LAS bf16_t* QI = (LAS bf16_t*)(lds + C_QI);
    LAS bf16_t* PS = (LAS bf16_t*)(lds + C_PS); LAS float* OL = (LAS float*)(lds + C_OL);
    const int tid = mk_tid(), lane = tid & 63, wave = tid >> 6, c = tid & 127, seg = tid >> 7;
    const int G = gridDim.x;
    const int tb = wave & 1, vb = wave >> 1, lr = lane & 31, lh = lane >> 5;
    const unsigned psel = pair_sel(c & 1);
    int item = mk_bid();
    Tile2 tq, tv, tz0, tz1, tg;
    if (item < NI) { const bf16_t* base = proj + (size_t)(item >> 2) * 64 * NCOL + (item & 3) * 128;
        tq = ld_tile(base + C_Q, tid); tv = ld_tile(base + C_I, tid); tz0 = ld_tile(base + C_FF, tid); tz1 = ld_tile(base + C_FB, tid); tg = ld_tile(base + C_G, tid); }
    int hcur = -1; float lbv[2] = {0.f, 0.f}; f32x4 gnv[4];
    for (; item < NI; item += G) {
        const int cg_ = item >> 2, h = item & 3;
        if (h != hcur) {
            hcur = h; lbv[0] = lb_value(p, l, 0, h * 128 + c); lbv[1] = lb_value(p, l, 1, h * 128 + c);
            const float* gnp = p.hg_norm_g + l * 512 + h * 128 + (tid & 7) * 16;
#pragma unroll
            for (int q4 = 0; q4 < 4; ++q4) gnv[q4] = *(const f32x4*)(gnp + q4 * 4);
        }
        st_tile((LAS bf16_t*)(lds + C_NQ), tq, tid); st_tile((LAS bf16_t*)(lds + C_NV), tv, tid);
        st_tile((LAS bf16_t*)(lds + C_NZ0), tz0, tid); st_tile((LAS bf16_t*)(lds + C_NZ1), tz1, tid);
        const Tile2 gcur = tg;
        { const int ni = item + G; if (ni < NI) { const bf16_t* base = proj + (size_t)(ni >> 2) * 64 * NCOL + (ni & 3) * 128;
            tq = ld_tile(base + C_Q, tid); tv = ld_tile(base + C_I, tid); tz0 = ld_tile(base + C_FF, tid); tz1 = ld_tile(base + C_FB, tid); tg = ld_tile(base + C_G, tid); } }
        lds_barrier();
        build_vt((const LAS bf16_t*)(lds + C_NV), VT, c, seg);
        float qv[16];
#pragma unroll
        for (int j = 0; j < 16; ++j) qv[j] = bf2f(((const LAS bf16_t*)(lds + C_NQ))[(seg * 16 + j) * NAT_LD + c]);
        float bb2[2][16], kk2[2][16];
#pragma unroll
        for (int dir = 0; dir < 2; ++dir) {
            float tot; gate16((const LAS bf16_t*)(lds + (dir ? C_NZ1 : C_NZ0)), c, seg, lbv[dir], dir, bb2[dir], kk2[dir], tot);
            TOT[(dir * 4 + seg) * 128 + c] = tot;
        }
        lds_barrier();
        f32x16 oacc = {};
#pragma unroll
        for (int dir = 0; dir < 2; ++dir) {
            const bf16_t* Sg = US + (size_t)(item * 2 + dir) * 16384 + (size_t)(vb * 32 + lr) * 128 + lh * 8;
            bf16x8 sf[8];
#pragma unroll
            for (int ks = 0; ks < 8; ++ks) sf[ks] = *(const bf16x8*)(Sg + ks * 16);
            float off, ref;
            { const float t0 = TOT[(dir * 4 + 0) * 128 + c], t1 = TOT[(dir * 4 + 1) * 128 + c], t2 = TOT[(dir * 4 + 2) * 128 + c], t3 = TOT[(dir * 4 + 3) * 128 + c];
              if (dir == 0) { off = (seg > 0 ? t0 : 0.f) + (seg > 1 ? t1 : 0.f) + (seg > 2 ? t2 : 0.f); ref = t0 + t1; }
              else { off = (seg < 3 ? t3 : 0.f) + (seg < 2 ? t2 : 0.f) + (seg < 1 ? t1 : 0.f); ref = t2 + t3; } }
            if (dir == 1) lds_barrier();
#pragma unroll
            for (int j = 0; j < 16; j += 2) {
                const float b0 = bb2[dir][j] + off, b1 = bb2[dir][j + 1] + off;
                const int wofs = (seg * 16 + j + (c & 1)) * NAT_LD + (c & ~1);
                const unsigned wq = pk2(qv[j] * fexp2(b0 - ref), qv[j + 1] * fexp2(b1 - ref));
                const unsigned wk = pk2(kk2[dir][j] * fexp2(ref - b0), kk2[dir][j + 1] * fexp2(ref - b1));
                const unsigned wi = pk2(qv[j] * fexp2(b0), qv[j + 1] * fexp2(b1));
                *(LAS unsigned*)(QS + wofs) = pair_word(wq, psel);
                *(LAS unsigned*)(KS + wofs) = pair_word(wk, psel);
                *(LAS unsigned*)(QI + wofs) = pair_word(wi, psel);
            }
            lds_barrier();
            {
                const int tm = wave & 3, tn0 = (wave >> 2) * 2, r16 = lane & 15, q4 = lane >> 4;
                f32x4 s0 = {}, s1 = {};
#pragma unroll
                for (int ks = 0; ks < 4; ++ks) {
                    const bf16x8 af = lds_frag(QS, tm * 16 + r16, NAT_LD, ks * 32 + q4 * 8);
                    const bf16x8 b0 = lds_frag(KS, tn0 * 16 + r16, NAT_LD, ks * 32 + q4 * 8);
                    const bf16x8 b1 = lds_frag(KS, tn0 * 16 + 16 + r16, NAT_LD, ks * 32 + q4 * 8);
                    s0 = __builtin_amdgcn_mfma_f32_16x16x32_bf16(af, b0, s0, 0, 0, 0);
                    s1 = __builtin_amdgcn_mfma_f32_16x16x32_bf16(af, b1, s1, 0, 0, 0);
                }
#pragma unroll
                for (int r = 0; r < 4; ++r) {
                    const int t = tm * 16 + q4 * 4 + r, sa = tn0 * 16 + r16, sb = sa + 16;
                    const bool ka = dir == 0 ? (sa <= t) : (sa >= t), kb = dir == 0 ? (sb <= t) : (sb >= t);
                    PS[t * T64_LD + sa] = (bf16_t)(pk2(ka ? s0[r] : 0.f, 0.f) & 0xffffu);
                    PS[t * T64_LD + sb] = (bf16_t)(pk2(kb ? s1[r] : 0.f, 0.f) & 0xffffu);
                }
            }
            lds_barrier();
#pragma unroll
            for (int ks = 0; ks < 4; ++ks) {
                const bf16x8 af = lds_frag(PS, tb * 32 + lr, T64_LD, ks * 16 + lh * 8);
                const bf16x8 bfm = lds_frag(VT, vb * 32 + lr, T64_LD, ks * 16 + lh * 8);
                oacc = __builtin_amdgcn_mfma_f32_32x32x16_bf16(af, bfm, oacc, 0, 0, 0);
            }
#pragma unroll
            for (int ks = 0; ks < 8; ++ks) {
                const bf16x8 af = lds_frag(QI, tb * 32 + lr, NAT_LD, ks * 16 + lh * 8);
                oacc = __builtin_amdgcn_mfma_f32_32x32x16_bf16(af, sf[ks], oacc, 0, 0, 0);
            }
        }
        lds_barrier();
#pragma unroll
        for (int i = 0; i < 4; ++i)
#pragma unroll
            for (int j = 0; j < 4; ++j) OL[(tb * 32 + 8 * i + 4 * lh + j) * 132 + vb * 32 + lr] = oacc[4 * i + j];
        lds_barrier();
        {
            const int t = tid >> 3, v0 = (tid & 7) * 16;
            float ov[16]; float ss = 0.f;
#pragma unroll
            for (int j = 0; j < 16; ++j) { ov[j] = OL[t * 132 + v0 + j]; ss += ov[j] * ov[j]; }
            ss += __shfl_xor(ss, 1, 64); ss += __shfl_xor(ss, 2, 64); ss += __shfl_xor(ss, 4, 64);
            const float rstd = rsqrtf(ss * (1.0f / 128.f) + EPS);
            unsigned w[8];
#pragma unroll
            for (int j = 0; j < 8; ++j) {
                const unsigned gw = j < 4 ? gcur.a[j] : gcur.b[j - 4];
                const float g0 = bflo(gw), g1 = bfhi(gw);
                const float y0 = ov[2 * j] * rstd * gnv[j >> 1][(2 * j) & 3] * g0 * frcp(1.0f + __expf(-g0)), y1 = ov[2 * j + 1] * rstd * gnv[j >> 1][(2 * j + 1) & 3] * g1 * frcp(1.0f + __expf(-g1));
                w[j] = pk2(y0, y1);
            }
            u32x4 a, bb; a[0] = w[0]; a[1] = w[1]; a[2] = w[2]; a[3] = w[3]; bb[0] = w[4]; bb[1] = w[5]; bb[2] = w[6]; bb[3] = w[7];
            bf16_t* mp = mix + (size_t)(cg_ * 64 + t) * DM + h * 128 + v0;
            *(u32x4*)mp = a; *(u32x4*)(mp + 8) = bb;
        }
        lds_barrier();
    }
}

constexpr int L_WS = 0, L_VT2 = 34816, L_GB = 69632;
__device__ void sg_items(LAS unsigned char* lds, const Params& p, int l, const bf16_t* proj, bf16_t* mix, const int NI) {
    LAS bf16_t* WS = (LAS bf16_t*)(lds + L_WS); LAS bf16_t* VT2 = (LAS bf16_t*)(lds + L_VT2); LAS float* GB = (LAS float*)(lds + L_GB);
    const int tid = mk_tid(), lane = tid & 63, wave = tid >> 6;
    const int G = gridDim.x;
    int item = mk_bid();
    const bool hconst = (G & 3) == 0;
    int hcur = -1; float bsv[2] = {0.f, 0.f};
    for (; item < NI; item += G) {
        const int ck = item >> 2, h = item & 3;
        const int pos = tid >> 2, q0 = (tid & 3) * 32;
        const bf16_t* vp = proj + (size_t)(ck * 128 + pos) * NCOL + C_V + h * 128 + q0;
        u32x4 vr[4];
#pragma unroll
        for (int q = 0; q < 4; ++q) vr[q] = *(const u32x4*)(vp + q * 8);
        if (!hconst || hcur != h) {
            if (hcur >= 0) lds_barrier();
            hcur = h;
            bsv[0] = p.sg_b[(l * 4 + h) * 128 + (wave >> 2) * 64 + (lane & 31)]; bsv[1] = p.sg_b[(l * 4 + h) * 128 + (wave >> 2) * 64 + 32 + (lane & 31)];
            const int r = tid >> 2, c0 = (tid & 3) * 32;
            const float* s = p.sg_w + ((size_t)(l * 4 + h) * 128 + r) * 128 + c0;
            f32x4 wv[8];
#pragma unroll
            for (int q = 0; q < 8; ++q) wv[q] = *(const f32x4*)(s + q * 4);
#pragma unroll
            for (int q = 0; q < 4; ++q) {
                u32x4 o; o[0] = pk2(wv[2 * q][0], wv[2 * q][1]); o[1] = pk2(wv[2 * q][2], wv[2 * q][3]); o[2] = pk2(wv[2 * q + 1][0], wv[2 * q + 1][1]); o[3] = pk2(wv[2 * q + 1][2], wv[2 * q + 1][3]);
                *(LAS u32x4*)(WS + r * NAT_LD + c0 + q * 8) = o;
            }
            if (tid < 128) GB[tid] = p.sg_norm_g[l * 512 + h * 128 + tid]; else if (tid < 256) GB[tid] = p.sg_norm_b[l * 512 + h * 128 + tid - 128];
            lds_barrier();
        }
        {
            float x[32]; float sum = 0.f;
#pragma unroll
            for (int q = 0; q < 4; ++q)
#pragma unroll
                for (int j = 0; j < 4; ++j) { x[q * 8 + 2 * j] = gelu_t(bflo(vr[q][j])); x[q * 8 + 2 * j + 1] = gelu_t(bfhi(vr[q][j])); }
#pragma unroll
            for (int j = 0; j < 32; ++j) sum += x[j];
            sum += __shfl_xor(sum, 1, 64); sum += __shfl_xor(sum, 2, 64);
            const float mu = sum * (1.0f / 128.f);
            float var = 0.f;
#pragma unroll
            for (int j = 0; j < 32; ++j) { x[j] -= mu; var += x[j] * x[j]; }
            var += __shfl_xor(var, 1, 64); var += __shfl_xor(var, 2, 64);
            const float rstd = rsqrtf(var * (1.0f / 128.f) + EPS);
#pragma unroll
            for (int j = 0; j < 32; ++j) {
                const float y = x[j] * rstd * GB[q0 + j] + GB[128 + q0 + j];
                VT2[(q0 + j) * NAT_LD + pos] = (bf16_t)(pk2(y, 0.f) & 0xffffu);
            }
        }
        const int mb = wave & 3, nh = wave >> 2, lr = lane & 31, lh = lane >> 5;
        u32x2 uw[2][4];
#pragma unroll
        for (int nt = 0; nt < 2; ++nt)
#pragma unroll
            for (int i = 0; i < 4; ++i) uw[nt][i] = *(const u32x2*)(proj + (size_t)(ck * 128 + nh * 64 + nt * 32 + lr) * NCOL + C_U + h * 128 + mb * 32 + 8 * i + 4 * lh);
        lds_barrier();
        f32x16 acc0 = {}, acc1 = {};
#pragma unroll
        for (int ks = 0; ks < 8; ++ks) {
            const bf16x8 af = lds_frag(VT2, mb * 32 + lr, NAT_LD, ks * 16 + lh * 8);
            const bf16x8 b0 = lds_frag(WS, nh * 64 + lr, NAT_LD, ks * 16 + lh * 8);
            const bf16x8 b1 = lds_frag(WS, nh * 64 + 32 + lr, NAT_LD, ks * 16 + lh * 8);
            acc0 = __builtin_amdgcn_mfma_f32_32x32x16_bf16(af, b0, acc0, 0, 0, 0);
            acc1 = __builtin_amdgcn_mfma_f32_32x32x16_bf16(af, b1, acc1, 0, 0, 0);
        }
#pragma unroll
        for (int nt = 0; nt < 2; ++nt) {
            const int pp = nh * 64 + nt * 32 + lr;
            const float bs = bsv[nt];
            bf16_t* mp = mix + (size_t)(ck * 128 + pp) * DM + 512 + h * 128;
#pragma unroll
            for (int i = 0; i < 4; ++i) {
                const int d = mb * 32 + 8 * i + 4 * lh;
                const float a0 = (nt ? acc1[4 * i] : acc0[4 * i]) + bs, a1 = (nt ? acc1[4 * i + 1] : acc0[4 * i + 1]) + bs;
                const float a2 = (nt ? acc1[4 * i + 2] : acc0[4 * i + 2]) + bs, a3 = (nt ? acc1[4 * i + 3] : acc0[4 * i + 3]) + bs;
                u32x2 o; o[0] = pk2(gelu_t(bflo(uw[nt][i][0])) * a0, gelu_t(bfhi(uw[nt][i][0])) * a1); o[1] = pk2(gelu_t(bflo(uw[nt][i][1])) * a2, gelu_t(bfhi(uw[nt][i][1])) * a3);
                *(u32x2*)(mp + d) = o;
            }
        }
        lds_barrier();
    }
}

__device__ void conv_fixup(const Params& p, int l, int pr, const bf16_t* HB, bf16_t* act) {
    const int SL = pr == 0 ? 4096 : 16384;
    constexpr int CG = DFF / 8;
    const int nitems = CG * 512 * 2;
    const float* cw = p.conv_w + (size_t)l * 3 * NFF; const float* cb = p.conv_b + (size_t)l * NFF;
    const u32x4 zero = {0u, 0u, 0u, 0u};
    for (int item = mk_bid() * NTHR + mk_tid(); item < nitems; item += gridDim.x * NTHR) {
        const int cgp = item % CG, rest = item / CG, which = rest & 1, blk = rest >> 1, c0 = cgp * 8;
        const int t = blk * 64 + (which ? 63 : 0);
        u32x4 rows[2][3];
#pragma unroll
        for (int s = 0; s < 2; ++s) {
            const bf16_t* hb = HB + s * DFF + c0;
            if (which == 0) {
                rows[s][0] = (t % SL == 0) ? zero : *(const u32x4*)(hb + (size_t)((blk - 1) * 4 + 3) * NFF);
                rows[s][1] = *(const u32x4*)(hb + (size_t)(blk * 4 + 0) * NFF);
                rows[s][2] = *(const u32x4*)(hb + (size_t)(blk * 4 + 1) * NFF);
            } else {
                rows[s][0] = *(const u32x4*)(hb + (size_t)(blk * 4 + 2) * NFF);
                rows[s][1] = *(const u32x4*)(hb + (size_t)(blk * 4 + 3) * NFF);
                rows[s][2] = ((t + 1) % SL == 0) ? zero : *(const u32x4*)(hb + (size_t)((blk + 1) * 4 + 0) * NFF);
            }
        }
        float r[2][8];
#pragma unroll
        for (int s = 0; s < 2; ++s) {
            f32x4 w[3][2], bb[2];
#pragma unroll
            for (int k = 0; k < 3; ++k) { w[k][0] = *(const f32x4*)(cw + k * NFF + s * DFF + c0); w[k][1] = *(const f32x4*)(cw + k * NFF + s * DFF + c0 + 4); }
            bb[0] = *(const f32x4*)(cb + s * DFF + c0); bb[1] = *(const f32x4*)(cb + s * DFF + c0 + 4);
#pragma unroll
            for (int j = 0; j < 4; ++j) {
                r[s][2 * j] = w[0][j >> 1][(2 * j) & 3] * bflo(rows[s][0][j]) + w[1][j >> 1][(2 * j) & 3] * bflo(rows[s][1][j]) + w[2][j >> 1][(2 * j) & 3] * bflo(rows[s][2][j]) + bb[j >> 1][(2 * j) & 3];
                r[s][2 * j + 1] = w[0][j >> 1][(2 * j + 1) & 3] * bfhi(rows[s][0][j]) + w[1][j >> 1][(2 * j + 1) & 3] * bfhi(rows[s][1][j]) + w[2][j >> 1][(2 * j + 1) & 3] * bfhi(rows[s][2][j]) + bb[j >> 1][(2 * j + 1) & 3];
            }
        }
        u32x4 o;
#pragma unroll
        for (int j = 0; j < 4; ++j) o[j] = pk2(r[0][2 * j] * frcp(1.0f + __expf(-r[0][2 * j])) * r[1][2 * j], r[0][2 * j + 1] * frcp(1.0f + __expf(-r[0][2 * j + 1])) * r[1][2 * j + 1]);
        *(u32x4*)(act + (size_t)t * DFF + c0) = o;
    }
}

constexpr int NPHASE = 34;
__device__ __forceinline__ bool phase_empty(int) { return false; }
__device__ __forceinline__ void zero_u64(u64* p, int n) { for (int i = mk_bid() * NTHR + mk_tid(); i < n; i += gridDim.x * NTHR) p[i] = 0ull; }

__device__ __forceinline__ void run_phase(LAS unsigned char* lds, const Params& p, int ph) {
    unsigned char* ws = p.ws;
    if (ph == 0) {
        for (int l = 0; l < DEPTH; ++l) {
            transpose_convert(lds, p.w_in + (size_t)l * DM * NCOL, (bf16_t*)(ws + WS_WIN + l * SZ_WIN), DM, NCOL, mk_bid(), gridDim.x, p.norm1_g + l * DM);
            transpose_convert(lds, p.w_out + (size_t)l * DM * DM, (bf16_t*)(ws + WS_WOUT + l * SZ_WOUT), DM, DM, mk_bid(), gridDim.x, nullptr);
            transpose_convert(lds, p.w_ffn_in + (size_t)l * DM * NFF, (bf16_t*)(ws + WS_WFI + l * SZ_WFI), DM, NFF, mk_bid(), gridDim.x, p.norm2_g + l * DM);
            transpose_convert(lds, p.w_ffn_out + (size_t)l * DFF * DM, (bf16_t*)(ws + WS_WFO + l * SZ_WFO), DFF, DM, mk_bid(), gridDim.x, nullptr);
        }
        for (int i = mk_bid() * NTHR + mk_tid(); i < DEPTH * DFF * 8; i += gridDim.x * NTHR) {
            const int j = i & 7, c = (i >> 3) % DFF, l = i / (8 * DFF), s2 = j >> 2, k = j & 3;
            ((float*)(ws + WS_CT))[i] = k < 3 ? p.conv_w[((size_t)l * 3 + k) * NFF + s2 * DFF + c] : p.conv_b[(size_t)l * NFF + s2 * DFF + c];
        }
        prepass_rows(p.x_prompt, (bf16_t*)(ws + WS_XB), (u64*)(ws + WS_SS1), 2 * GT);
        prepass_rows(p.x_sample, (bf16_t*)(ws + WS_XB) + (size_t)2 * GT * DM, (u64*)(ws + WS_SS1) + 2 * GT, 2 * GT);
        return;
    }
    if (ph == NPHASE - 1) { final_rows((const bf16_t*)(ws + WS_XB), (const u64*)(ws + WS_SS1), p.final_g, p.out, NGROUP * GT); return; }
    const int q = ph - 1, k = q & 7, pl = q >> 3, l = pl & 1, pr = pl >> 1;
    bf16_t* XBP = (bf16_t*)(ws + WS_XB) + (size_t)pr * PT * DM;
    u64* SS1 = (u64*)(ws + WS_SS1) + (size_t)pr * PT; u64* SS2 = (u64*)(ws + WS_SS2);
    bf16_t* PROJ = (bf16_t*)(ws + WS_PROJ); bf16_t* US = (bf16_t*)((unsigned char*)p.out + OUT_US); float* Dd = (float*)((unsigned char*)p.out + OUT_D);
    bf16_t* MIX = (bf16_t*)(ws + WS_MIX); bf16_t* ACT = (bf16_t*)(ws + WS_ACT);
    switch (k) {
    case 0: {
        pg8::Gemm gm; gm.A = XBP; gm.M = PT; gm.K = DM; gm.Bt = (const bf16_t*)(ws + WS_WIN + l * SZ_WIN); gm.N = NCOL;
        pg8::StaticOrder S; S.init(PT, NCOL, gridDim.x, mk_bid());
        EpiB16 E; E.O = PROJ; E.ldc = NCOL; E.SS = SS1;
        pg8::gemm_phase<EpiB16, pg8::StaticOrder, false>(lds, gm, S, E, nullptr);
    } break;
    case 1: zero_u64(SS2, PT);
            hgrn_states(lds, p, l, PROJ, US, Dd, 2048); sg_items(lds, p, l, PROJ, MIX, 1024); break;
    case 2: zero_u64(SS1, PT);
            hgrn_scan(pr, US, Dd); break;
    case 3: hgrn_out(lds, p, l, PROJ, US, MIX, 2048); break;
    case 4: {
        pg8::Gemm gm; gm.M = PT; gm.N = DM; gm.A = MIX; gm.Bt = (const bf16_t*)(ws + WS_WOUT + l * SZ_WOUT); gm.K = DM;
        pg8::StaticOrder S; S.init(PT, DM, gridDim.x, mk_bid());
        EpiRes E; E.X = XBP; E.SS = SS2;
        pg8::gemm_phase<EpiRes, pg8::StaticOrder, false>(lds, gm, S, E, nullptr);
    } break;
    case 5: {
        pg8::Gemm gm; gm.A = XBP; gm.M = PT; gm.K = DM; gm.Bt = (const bf16_t*)(ws + WS_WFI + l * SZ_WFI); gm.N = NFF;
        gm.bh = (size_t)DFF * DM * 2; gm.bt = (size_t)128 * DM * 2;
        pg8::StaticOrder S; S.init(PT, NFF, gridDim.x, mk_bid());
        EpiConv E; E.ACT = ACT; E.HB = (bf16_t*)(ws + WS_HB); E.SS = SS2; E.CT = (const float*)(ws + WS_CT) + (size_t)l * DFF * 8; E.CTW = (LAS float*)(lds + LDS_CTW_OFF);
        pg8::gemm_phase<EpiConv, pg8::StaticOrder, false>(lds, gm, S, E, nullptr);
    } break;
    case 6: conv_fixup(p, l, pr, (const bf16_t*)(ws + WS_HB), ACT); break;
    case 7: {
        pg8::Gemm gm; gm.M = PT; gm.N = DM; gm.A = ACT; gm.Bt = (const bf16_t*)(ws + WS_WFO + l * SZ_WFO); gm.K = DFF;
        pg8::StaticOrder S; S.init(PT, DM, gridDim.x, mk_bid());
        EpiRes E; E.X = XBP; E.SS = SS1;
        pg8::gemm_phase<EpiRes, pg8::StaticOrder, false>(lds, gm, S, E, nullptr);
    } break;
    }
}

#ifdef DBG_STOP
__device__ void dbg_phase(const Params& p, int ph) {
    float* acc = (float*)(p.ws + WS_END);
    const int tid = mk_tid(), bid = mk_bid();
    if (ph == 100) { if (bid == 0 && tid < 2) acc[tid] = 0.f; return; }
    if (ph == 101) {
        const size_t n = (size_t)DBG_N; float ss = 0.f, nf = 0.f;
        for (size_t i = (size_t)bid * NTHR + tid; i < n; i += (size_t)gridDim.x * NTHR) {
#if DBG_F32
            const float v = DBG_F32 == 2 ? p.out[i] : ((const float*)(p.ws + DBG_OFF))[i];
#else
            const float v = bf2f(((const bf16_t*)(p.ws + DBG_OFF))[i]);
#endif
            if (fabsf(v) < 1e30f) ss += v * v; else nf += 1.f;
        }
        ss = wave_sum(ss); nf = wave_sum(nf);
        if ((tid & 63) == 0) { atomicAdd(acc, ss); atomicAdd(acc + 1, nf); }
        return;
    }
    if (ph == 102) {
        const float stat = (DBG_KIND == 0 ? acc[0] : acc[1]) / (float)DBG_N;
        const float c = sqrtf((stat + 1e-6f) * 1e6f);
        for (size_t i = (size_t)bid * NTHR + tid; i < (size_t)NGROUP * GT * DM; i += (size_t)gridDim.x * NTHR) p.out[i] = c;
    }
}
#endif
__global__ void __launch_bounds__(NTHR, 2) mega(Params p) {
    extern __shared__ __attribute__((aligned(16))) unsigned char smem[];
    LAS unsigned char* lds = (LAS unsigned char*)smem;
    cg::grid_group grid = cg::this_grid();
#if ONE_LAUNCH
    volatile LAS unsigned* st = (volatile LAS unsigned*)(lds + LDS_BAR_OFF);
    if (mk_tid() < 4) st[mk_tid()] = 0u;
    __syncthreads();
    XcdBarrier bar = xcd_barrier_post((unsigned*)(p.ws + WS_BAR), st);
#endif
#ifdef DBG_TIME
    unsigned long long* TS = (unsigned long long*)(p.ws + WS_TS);
    if (mk_bid() == 0 && mk_tid() == 0) TS[0] = __builtin_amdgcn_s_memrealtime();
#endif
    for (int ph = p.ph_lo; ph < p.ph_hi; ++ph) {
#ifdef DBG_STOP
        if (ph >= 100) { dbg_phase(p, ph); continue; }
#endif
        if (phase_empty(ph)) continue;
        run_phase(lds, p, ph);
#if ONE_LAUNCH
        if (ph + 1 < p.ph_hi) { if (p.ph_lo < 0) grid.sync(); else xcd_barrier(bar); }
#endif
#ifdef DBG_TIME
        if (mk_bid() == 0 && mk_tid() == 0) TS[ph + 1] = __builtin_amdgcn_s_memrealtime();
#endif
    }
#ifdef DBG_TIME
    xcd_barrier(bar);
    {
        float s1 = 0.f, s2 = 0.f;
        for (int ph = 0; ph < NPHASE; ++ph) {
            const int kind = ph == 0 ? 0 : (ph == NPHASE - 1 ? 9 : 1 + ((ph - 1) & 7));
            const float d = (float)(TS[ph + 1] - TS[ph]);
            if (kind == DBG_K1) s1 += d; if (kind == DBG_K2) s2 += d;
        }
        s1 = exp2f(0.5f * rintf(2.0f * log2f(fmaxf(s1, 1.f)))); s2 = exp2f(0.5f * rintf(2.0f * log2f(fmaxf(s2, 1.f))));
        const float c = sqrtf(s1);
        for (size_t i = (size_t)mk_bid() * NTHR + mk_tid(); i < (size_t)NGROUP * GT * DM; i += (size_t)gridDim.x * NTHR) p.out[i] = (i == 0) ? s2 : c;
    }
#endif
}

#ifndef ONE_LAUNCH
#define ONE_LAUNCH 0
#endif

extern "C" void kernel_launch(void* const* d_in, const int* in_sizes, int n_in, void* d_out, int out_size, void* d_ws, size_t ws_size, hipStream_t stream) {
    static int grid = 0;
    if (grid == 0) {
        int dev = 0, cus = 0, per_cu = 0;
        hipGetDevice(&dev);
        hipDeviceGetAttribute(&cus, hipDeviceAttributeMultiprocessorCount, dev);
        if (hipFuncSetAttribute((const void*)mega, hipFuncAttributeMaxDynamicSharedMemorySize, LDS_BYTES) != hipSuccess) { fprintf(stderr, "hipFuncSetAttribute failed\n"); grid = -1; return; }
        if (hipOccupancyMaxActiveBlocksPerMultiprocessor(&per_cu, (const void*)mega, NTHR, LDS_BYTES) != hipSuccess || per_cu < 1) { fprintf(stderr, "occupancy query: %d\n", per_cu); per_cu = 1; }
        (void)hipGetLastError();
        grid = cus * 1;
        if (ws_size < WS_END) { fprintf(stderr, "workspace too small: %zu < %zu\n", ws_size, (size_t)WS_END); grid = -1; return; }
    }
    if (grid < 0) return;
    Params p{};
    p.x_prompt = (const float*)d_in[0]; p.x_sample = (const float*)d_in[1]; p.norm1_g = (const float*)d_in[2]; p.w_in = (const float*)d_in[3];
    p.lb_logits = (const float*)d_in[4]; p.hg_norm_g = (const float*)d_in[5]; p.sg_norm_g = (const float*)d_in[6]; p.sg_norm_b = (const float*)d_in[7];
    p.sg_w = (const float*)d_in[8]; p.sg_b = (const float*)d_in[9]; p.w_out = (const float*)d_in[10]; p.norm2_g = (const float*)d_in[11];
    p.w_ffn_in = (const float*)d_in[12]; p.conv_w = (const float*)d_in[13]; p.conv_b = (const float*)d_in[14]; p.w_ffn_out = (const float*)d_in[15];
    p.final_g = (const float*)d_in[16]; p.out = (float*)d_out; p.ws = (unsigned char*)d_ws;
#if ONE_LAUNCH
    (void)hipMemsetAsync((char*)d_ws + WS_BAR, 0, 16384, stream);
    p.ph_lo = 0; p.ph_hi = NPHASE;
    void* args[] = {&p};
    hipError_t e = hipLaunchCooperativeKernel((const void*)mega, dim3(grid), dim3(NTHR), args, LDS_BYTES, stream);
    if (e != hipSuccess) fprintf(stderr, "cooperative launch failed: %s (grid %d)\n", hipGetErrorString(e), grid);
#else
#ifdef DBG_STOP
    for (int ph = 0; ph <= 102; ++ph) {
        if (ph > DBG_STOP && ph < 100) continue;
        p.ph_lo = ph; p.ph_hi = ph + 1;
#else
    for (int ph = 0; ph < NPHASE; ++ph) {
        p.ph_lo = ph; p.ph_hi = ph + 1;
#endif
        hipLaunchKernelGGL(mega, dim3(grid), dim3(NTHR), LDS_BYTES, stream, p);
    }
#endif
}
```

```cpp
#include <hip/hip_runtime.h>
#include <hip/hip_cooperative_groups.h>
#include <cstdio>
namespace cg = cooperative_groups;
__device__ __forceinline__ int mk_tid() { int t = threadIdx.x; asm volatile("" : "+v"(t)); return t; }
__device__ __forceinline__ int mk_bid() { int t = blockIdx.x; asm volatile("" : "+s"(t)); return t; }
#define ONE_LAUNCH 1

namespace pg8 {
#define PG8_LAS __attribute__((address_space(3)))
typedef unsigned short bf16_t;
typedef short bf16x8 __attribute__((ext_vector_type(8)));
typedef float f32x4 __attribute__((ext_vector_type(4)));
typedef unsigned u32x4 __attribute__((ext_vector_type(4)));
constexpr int BM = 256, BK = 64, HALF = 128, HTB = HALF * BK * 2  , STAGE_BYTES = 8 * HTB, NXCD = 8, WGM = 4;

__host__ __device__ __forceinline__ int lds_byte(int r, int c) { const int st = (r >> 4) * 2 + (c >> 5), rr = r & 15, cc = c & 31, ob = rr * 64 + cc * 2; return st * 1024 + (ob ^ (((ob >> 9) & 1) << 5)); }
__host__ __device__ __forceinline__ void stage_rc(int b, int& R, int& C) { const int st = b / 1024, sb = b % 1024, swz = sb ^ (((sb >> 9) & 1) << 5); R = (st >> 1) * 16 + swz / 64; C = (st & 1) * 32 + (swz % 64) / 2; }
__host__ __device__ __forceinline__ int perm32(int rho) { const int n = rho >> 4, i = rho & 15; return 8 * (i >> 2) + 4 * n + (i & 3); }

struct Unit { int pm, pn; };
struct Gemm { const bf16_t* A; const bf16_t* Bt; int M, N, K; size_t bh = 0, bt = 0; };

struct StaticOrder {
    int nM, nN, nwg, G, c;
    __host__ __device__ void init(int M, int N, int G_, int c_) { nM = M / BM; nN = N / BM; nwg = nM * nN; G = G_; c = c_; }
    __host__ __device__ bool next(int i, Unit& u) const {
        const long L = (long)i * G + c; if (L >= nwg) return false;
        int wgid = (int)L; { const int q = nwg / NXCD, r = nwg % NXCD, xcd = wgid % NXCD, off = wgid / NXCD; wgid = (xcd < r ? xcd * (q + 1) : r * (q + 1) + (xcd - r) * q) + off; }
        const int nig = WGM * nN, gid = wgid / nig, fm = gid * WGM, gsz = (nM - fm) < WGM ? (nM - fm) : WGM;
        u.pm = fm + ((wgid % nig) % gsz); u.pn = (wgid % nig) / gsz; return true;
    }
    __device__ __forceinline__ void a_ready(const Unit&) const {}
    __device__ __forceinline__ void done(const Unit&) const {}
};
__device__ __forceinline__ unsigned cvt_pk_bf16(float lo, float hi) { unsigned r; asm("v_cvt_pk_bf16_f32 %0, %1, %2" : "=v"(r) : "v"(lo), "v"(hi)); return r; }
template <class Epi, class Sched, bool STAMP = false>
__device__ __forceinline__ void gemm_phase(PG8_LAS unsigned char* lds, const Gemm g, const Sched& S, const Epi& E, unsigned long long* stamps) {
    const int tid = mk_tid(), wid = __builtin_amdgcn_readfirstlane(tid >> 6), lane = tid & 63, wr = wid >> 2, wc = wid & 3, fr = lane & 15, fq = lane >> 4;
    const int K = g.K, nt = K / BK;
    int ts_lo = 0, ts_hi = 0, nts = 0; const unsigned long long rt_entry = STAMP ? (unsigned long long)wall_clock64() : 0ull;
#define PG8_STAMP() do { if (STAMP && wid == 0 && nts < 64) { const unsigned long long _c = (unsigned long long)clock64(); \
        ts_lo = (lane == nts) ? (int)(unsigned)_c : ts_lo; ts_hi = (lane == nts) ? (int)(unsigned)(_c >> 32) : ts_hi; ++nts; } } while (0)
    PG8_STAMP();
    unsigned voffA[2], voffB[2];
#pragma unroll
    for (int i = 0; i < 2; ++i) { int R, C; stage_rc(tid * 16 + i * 8192, R, C); const int Rb = Epi::PERM ? ((R & ~31) + perm32(R & 31)) : R;
        voffA[i] = (unsigned)(R * K + C) * 2u; voffB[i] = (unsigned)(Rb * K + C) * 2u; }
    const size_t kstep = (size_t)(BK * 2);
    const size_t hstep = (size_t)HALF * K * 2;
    const size_t tstep = 2 * hstep;
    const size_t hstepB = g.bh ? g.bh : hstep, tstepB = g.bt ? g.bt : tstep;
    const unsigned ldsw = (unsigned)wid * 1024u;
    const int aoff = lds_byte(wr * 64 + fr, fq * 8), boff = lds_byte(wc * 32 + fr, fq * 8);
#define PG8_SA(b, h) (((b) * 2 + (h)) * HTB)
#define PG8_SB(b, h) ((4 + (b) * 2 + (h)) * HTB)
#define PG8_STAGE(bufoff, gbase, voff) do { _Pragma("unroll") for (int _i = 0; _i < 2; ++_i) \
        __builtin_amdgcn_global_load_lds((const unsigned*)((const char*)(gbase) + (voff)[_i]), (PG8_LAS unsigned*)(lds + (bufoff) + ldsw + _i * 8192), 16, 0, 0); } while (0)
#define PG8_LDA(dst, b, h) do { _Pragma("unroll") for (int m = 0; m < 4; ++m) _Pragma("unroll") for (int k = 0; k < 2; ++k) dst[m][k] = *(const PG8_LAS bf16x8*)(lds + PG8_SA(b, h) + aoff + m * 2048 + k * 1024); } while (0)
#define PG8_LDB(dst, b, h) do { _Pragma("unroll") for (int n = 0; n < 2; ++n) _Pragma("unroll") for (int k = 0; k < 2; ++k) dst[n][k] = *(const PG8_LAS bf16x8*)(lds + PG8_SB(b, h) + boff + n * 2048 + k * 1024); } while (0)
#define PG8_MMA(ai, bj, At, Bt) do { __builtin_amdgcn_s_setprio(1); _Pragma("unroll") for (int m = 0; m < 4; ++m) _Pragma("unroll") for (int n = 0; n < 2; ++n) _Pragma("unroll") for (int k = 0; k < 2; ++k) \
        acc[ai][bj][m][n] = __builtin_amdgcn_mfma_f32_16x16x32_bf16(Bt[n][k], At[m][k], acc[ai][bj][m][n], 0, 0, 0); __builtin_amdgcn_s_setprio(0); } while (0)
#define PG8_WAIT_V(n) asm volatile("s_waitcnt vmcnt(" #n ")" ::: "memory")
#define PG8_WAIT_L(n) asm volatile("s_waitcnt lgkmcnt(" #n ")" ::: "memory")
#define PG8_BAR __builtin_amdgcn_s_barrier()
#define PG8_SCHED __builtin_amdgcn_sched_barrier(0)
    Unit cur, nxt; int ui = 0;
    if (!S.next(0, cur)) return;
    f32x4 acc[2][2][4][2];
#pragma unroll
    for (int a = 0; a < 2; ++a)
#pragma unroll
        for (int b = 0; b < 2; ++b)
#pragma unroll
            for (int m = 0; m < 4; ++m)
#pragma unroll
                for (int n = 0; n < 2; ++n) acc[a][b][m][n] = (f32x4){0.f, 0.f, 0.f, 0.f};
    bf16x8 At[4][2], B0[2][2], B1[2][2];
    const char* cA = (const char*)g.A + (size_t)cur.pm * tstep; const char* cB = (const char*)g.Bt + (size_t)cur.pn * tstepB;
    S.a_ready(cur);
    E.pre(cur, wr, wc, fr, fq);
    E.commit();
    PG8_STAGE(PG8_SB(0, 0), cB, voffB); PG8_STAGE(PG8_SA(0, 0), cA, voffA); PG8_STAGE(PG8_SB(0, 1), cB + hstepB, voffB); PG8_STAGE(PG8_SA(0, 1), cA + hstep, voffA);
    if (wr == 1) PG8_BAR;
    PG8_WAIT_V(4); PG8_BAR;
    PG8_STAGE(PG8_SB(1, 0), cB + kstep, voffB); PG8_STAGE(PG8_SA(1, 0), cA + kstep, voffA); PG8_STAGE(PG8_SB(1, 1), cB + hstepB + kstep, voffB);
    PG8_WAIT_V(6); PG8_BAR;
    PG8_STAMP();
    for (;;) {
        const bool has_next = S.next(ui + 1, nxt);
        const char* nA = has_next ? (const char*)g.A + (size_t)nxt.pm * tstep : cA; const char* nB = has_next ? (const char*)g.Bt + (size_t)nxt.pn * tstepB : cB;
        for (int t = 0; t < nt; t += 2) {
            const bool last = (t == nt - 2);
            const char* a1 = cA + (size_t)(t + 1) * kstep;
            const char* a2 = last ? nA : cA + (size_t)(t + 2) * kstep; const char* b2 = last ? nB : cB + (size_t)(t + 2) * kstep;
            const char* a3 = a2 + kstep; const char* b3 = b2 + kstep;
            if (last && has_next) { S.a_ready(nxt); E.pre(nxt, wr, wc, fr, fq); }
            PG8_LDB(B0, 0, 0); PG8_SCHED; PG8_LDA(At, 0, 0); PG8_STAGE(PG8_SA(1, 1), a1 + hstep, voffA);
            PG8_WAIT_L(8); PG8_BAR; PG8_WAIT_L(0); PG8_MMA(0, 0, At, B0); PG8_BAR; PG8_SCHED;
            PG8_LDB(B1, 0, 1); PG8_STAGE(PG8_SB(0, 0), b2, voffB);
            PG8_BAR; PG8_WAIT_L(0); PG8_MMA(0, 1, At, B1); PG8_BAR;
            PG8_LDA(At, 0, 1); PG8_STAGE(PG8_SA(0, 0), a2, voffA);
            PG8_BAR; PG8_WAIT_L(0); PG8_MMA(1, 0, At, B0); PG8_BAR; PG8_SCHED;
            PG8_STAGE(PG8_SB(0, 1), b2 + hstepB, voffB);
            PG8_WAIT_V(6); PG8_BAR; PG8_MMA(1, 1, At, B1); PG8_BAR;
            PG8_LDB(B0, 1, 0); PG8_SCHED; PG8_LDA(At, 1, 0); PG8_STAGE(PG8_SA(0, 1), a2 + hstep, voffA);
            PG8_WAIT_L(8); PG8_BAR; PG8_WAIT_L(0); PG8_MMA(0, 0, At, B0); PG8_BAR; PG8_SCHED;
            PG8_LDB(B1, 1, 1); PG8_STAGE(PG8_SB(1, 0), b3, voffB);
            PG8_BAR; PG8_WAIT_L(0); PG8_MMA(0, 1, At, B1); PG8_BAR;
            PG8_LDA(At, 1, 1); PG8_STAGE(PG8_SA(1, 0), a3, voffA);
            PG8_BAR; PG8_WAIT_L(0); PG8_MMA(1, 0, At, B0); PG8_BAR; PG8_SCHED;
            PG8_STAGE(PG8_SB(1, 1), b3 + hstepB, voffB);
            PG8_WAIT_V(6); PG8_BAR; PG8_MMA(1, 1, At, B1); PG8_BAR;
        }
        PG8_STAMP();
        if constexpr (!Epi::AFTER_DRAIN) { E(acc, cur, wr, wc, fr, fq); E.commit(); S.done(cur); }
        PG8_STAMP();
        if (!has_next) break;
#pragma unroll
        for (int a = 0; a < 2; ++a)
#pragma unroll
            for (int b = 0; b < 2; ++b)
#pragma unroll
                for (int m = 0; m < 4; ++m)
#pragma unroll
                    for (int n = 0; n < 2; ++n) acc[a][b][m][n] = (f32x4){0.f, 0.f, 0.f, 0.f};
        cur = nxt; cA = nA; cB = nB; ++ui;
    }
    PG8_WAIT_V(0);
    if (wr == 0) PG8_BAR;
    PG8_BAR;
    if constexpr (Epi::AFTER_DRAIN) { E.fused(acc, cur, wr, wc, fr, fq, lds, wid, lane); S.done(cur); }
    PG8_STAMP();
    if (STAMP && wid == 0) { stamps[lane] = lane < nts ? (((unsigned long long)(unsigned)ts_hi << 32) | (unsigned)ts_lo) : 0ull;
        if (lane == 62) stamps[62] = rt_entry; if (lane == 63) stamps[63] = (unsigned long long)wall_clock64(); }
#undef PG8_STAMP
#undef PG8_SA
#undef PG8_SB
#undef PG8_STAGE
#undef PG8_LDA
#undef PG8_LDB
#undef PG8_MMA
#undef PG8_WAIT_V
#undef PG8_WAIT_L
#undef PG8_BAR
#undef PG8_SCHED
}
}
#define LAS __attribute__((address_space(3)))
#define XB_TMO      128
#define XB_XCNT(j)  (256  + 64 * (j))
#define XB_XSUB(j)  (1280 + 64 * (j))
#define XB_XGEN(j)  (2304 + 64 * (j))
#define XB_TOP      3328
#define XB_TOPGEN   3392
#define XCD_BAR_WORDS 3456
#define XB_SPIN_CAP (1u << 18)


__device__ __forceinline__ unsigned xb_ld(unsigned* p)              { return __hip_atomic_load(p, __ATOMIC_RELAXED, __HIP_MEMORY_SCOPE_AGENT); }
__device__ __forceinline__ unsigned xb_add(unsigned* p, unsigned v) { return __hip_atomic_fetch_add(p, v, __ATOMIC_RELAXED, __HIP_MEMORY_SCOPE_AGENT); }
__device__ __forceinline__ unsigned xb_xcc_id() { return (unsigned)__builtin_amdgcn_s_getreg((3 << 11) | 20) & 0xFu; }
#define XB_SPIN(cond, bar) do { unsigned _sp = 0; while (cond) { __builtin_amdgcn_s_sleep(1); \
    if ((++_sp & 255u) == 0u) { if (xb_ld(&(bar)[XB_TMO])) break; if (_sp > XB_SPIN_CAP) { atomicAdd(&(bar)[XB_TMO], 1u); break; } } } } while (0)

struct XcdBarrier {
    unsigned* bar; unsigned x;
    volatile LAS unsigned* st;
};

__device__ __forceinline__ XcdBarrier xcd_barrier_post(unsigned* bar, volatile LAS unsigned* st) {
    XcdBarrier b; b.bar = bar; b.x = xb_xcc_id(); b.st = st;
    if (mk_tid() == 0) (void)xb_add(&bar[XB_XCNT(b.x)], 1u);
    return b;
}
__device__ __forceinline__ void xcd_barrier_complete(unsigned* bar, unsigned x, unsigned& nloc, unsigned& nx) {
    const unsigned G = gridDim.x * gridDim.y * gridDim.z;
    unsigned sum, cnt, mine, sp = 0u;
    for (;;) {
        sum = 0u; cnt = 0u; mine = 0u;
#pragma unroll
        for (unsigned j = 0; j < 16; ++j) { const unsigned c = xb_ld(&bar[XB_XCNT(j)]); sum += c; cnt += (c > 0u) ? 1u : 0u; mine = (j == x) ? c : mine; }
        if (sum == G) break;
        __builtin_amdgcn_s_sleep(1);
        if ((++sp & 255u) == 0u) { if (xb_ld(&bar[XB_TMO])) break; if (sp > XB_SPIN_CAP) { atomicAdd(&bar[XB_TMO], 1u); break; } }
    }
    nloc = mine > 0u ? mine : 1u; nx = cnt > 0u ? cnt : 1u;
}

__device__ __forceinline__ void xcd_barrier(const XcdBarrier& b) {
    asm volatile("s_waitcnt vmcnt(0)" ::: "memory");
    __syncthreads();
    if (mk_tid() == 0) {
        unsigned* bar = b.bar;
        __builtin_amdgcn_s_waitcnt(0);
        unsigned nloc = b.st[0], nx = b.st[1];
        if (nloc == 0u) { xcd_barrier_complete(bar, b.x, nloc, nx); b.st[0] = nloc; b.st[1] = nx; }
        const unsigned old = xb_add(&bar[XB_XSUB(b.x)], 1u);
        const unsigned gen = old / nloc;
        if (old + 1u == (gen + 1u) * nloc) {
            __builtin_amdgcn_fence(__ATOMIC_RELEASE, "agent");
            asm volatile("s_waitcnt vmcnt(0)" ::: "memory");
            const unsigned og = xb_add(&bar[XB_TOP], 1u);
            const unsigned tg = og / nx;
            if (og + 1u == (tg + 1u) * nx) xb_add(&bar[XB_TOPGEN], 1u);
            else XB_SPIN(xb_ld(&bar[XB_TOPGEN]) == tg, bar);
            __builtin_amdgcn_fence(__ATOMIC_ACQUIRE, "agent");
            xb_add(&bar[XB_XGEN(b.x)], 1u);
            asm volatile("s_waitcnt vmcnt(0)" ::: "memory");
        } else {
            XB_SPIN(xb_ld(&bar[XB_XGEN(b.x)]) == gen, bar);
            __builtin_amdgcn_fence(__ATOMIC_ACQUIRE, "agent");
            asm volatile("s_waitcnt vmcnt(0)" ::: "memory");
        }
    }
    __syncthreads();
}

typedef unsigned short bf16_t;
typedef short bf16x8 __attribute__((ext_vector_type(8)));
typedef float f32x4 __attribute__((ext_vector_type(4)));
typedef float f32x16 __attribute__((ext_vector_type(16)));
typedef unsigned u32x4 __attribute__((ext_vector_type(4)));
typedef unsigned u32x2 __attribute__((ext_vector_type(2)));


constexpr int DM = 1024, NCOL = 3584, DFF = 2816, NFF = 5632;
constexpr int GT = 16384;
constexpr int NGROUP = 4, DEPTH = 2;
constexpr int NTHR = 512;
constexpr int LDS_BYTES = 131072 + 16 + 8192;
constexpr int LDS_CTW_OFF = 131072 + 16;
constexpr int LDS_BAR_OFF = 131072;
constexpr float EPS = 1e-6f;
constexpr int C_Q = 0, C_FF = 512, C_FB = 1024, C_I = 1536, C_G = 2048, C_U = 2560, C_V = 3072;

constexpr size_t SZ_WIN = (size_t)NCOL * DM * 2, SZ_WOUT = (size_t)DM * DM * 2, SZ_WFI = (size_t)NFF * DM * 2, SZ_WFO = (size_t)DM * DFF * 2;
constexpr size_t WS_WIN = 0;
constexpr size_t WS_WOUT = WS_WIN + 2 * SZ_WIN;
constexpr size_t WS_WFI = WS_WOUT + 2 * SZ_WOUT;
constexpr size_t WS_WFO = WS_WFI + 2 * SZ_WFI;
constexpr size_t WS_XB = WS_WFO + 2 * SZ_WFO;
constexpr int PT = 2 * GT;
constexpr size_t WS_PROJ = WS_XB + (size_t)NGROUP * GT * DM * 2;
constexpr size_t WS_ACT = WS_PROJ;
constexpr size_t WS_HB = WS_PROJ + (size_t)PT * DFF * 2;
static_assert((size_t)PT * DFF * 2 + (size_t)512 * 4 * NFF * 2 <= (size_t)PT * NCOL * 2, "act + halo alias proj");
constexpr size_t WS_MIX = WS_PROJ + (size_t)PT * NCOL * 2;
constexpr size_t OUT_US = 0;
constexpr size_t OUT_D = OUT_US + (size_t)512 * 8 * 16384 * 2;
static_assert(OUT_D + (size_t)512 * 8 * 128 * 4 <= (size_t)NGROUP * GT * DM * 4, "states fit the output buffer");
constexpr size_t WS_SS1 = WS_MIX + (size_t)PT * DM * 2;
constexpr size_t WS_SS2 = WS_SS1 + (size_t)NGROUP * GT * 8;
constexpr size_t WS_CT = WS_SS2 + (size_t)PT * 8;
constexpr size_t WS_BAR = WS_CT + (size_t)DEPTH * DFF * 8 * 4;
constexpr size_t WS_TS = WS_BAR + 16384;
constexpr size_t WS_END = WS_TS + 4096;

struct Params {
    const float* x_prompt; const float* x_sample; const float* norm1_g; const float* w_in; const float* lb_logits; const float* hg_norm_g;
    const float* sg_norm_g; const float* sg_norm_b; const float* sg_w; const float* sg_b; const float* w_out; const float* norm2_g;
    const float* w_ffn_in; const float* conv_w; const float* conv_b; const float* w_ffn_out; const float* final_g;
    float* out; unsigned char* ws; int ph_lo, ph_hi;
};

typedef __bf16 bf16x2_t __attribute__((ext_vector_type(2)));
typedef float f32x2_t __attribute__((ext_vector_type(2)));
__device__ __forceinline__ unsigned pk2(float lo, float hi) { f32x2_t v = {lo, hi}; bf16x2_t b = __builtin_convertvector(v, bf16x2_t); return __builtin_bit_cast(unsigned, b); }
__device__ __forceinline__ float bf2f(unsigned short b) { return __uint_as_float(((unsigned)b) << 16); }
__device__ __forceinline__ float bflo(unsigned w) { return __uint_as_float(w << 16); }
__device__ __forceinline__ float bfhi(unsigned w) { return __uint_as_float(w & 0xffff0000u); }
__device__ __forceinline__ float fast_exp(float x) { return __expf(x); }
__device__ __forceinline__ float gelu_t(float x) { const float y = 1.5957691216f * (x + 0.044715f * x * x * x); return x * __builtin_amdgcn_rcpf(1.0f + __expf(-y)); }
__device__ __forceinline__ float silu_f(float x) { return x * __builtin_amdgcn_rcpf(1.0f + __expf(-x)); }
__device__ __forceinline__ float wave_sum(float v) {
#pragma unroll
    for (int o = 32; o > 0; o >>= 1) v += __shfl_xor(v, o, 64);
    return v;
}

__device__ __forceinline__ void lds_barrier() { asm volatile("s_waitcnt lgkmcnt(0)\n\ts_barrier" ::: "memory"); }

typedef unsigned long long u64;
__device__ __forceinline__ u64 ss_fix(float v) { return (u64)(v * 16777216.0f + 0.5f); }
__device__ __forceinline__ float ss_rstd(u64 q) { return rsqrtf((float)q * (1.0f / 16777216.0f) * (1.0f / DM) + EPS); }
struct EpiB16 {
    static constexpr bool PERM = true, AFTER_DRAIN = false;
    bf16_t* O; int ldc; const u64* SS;
    mutable u64 cq[2];
    __device__ __forceinline__ void commit() const { cq[0] = pq[0]; cq[1] = pq[1]; }
    mutable u64 pq[2];
    __device__ __forceinline__ void pre(const pg8::Unit& u, int wr, int wc, int fr, int fq) const {
        const int r = u.pm * 256 + wr * 64 + fq * 16 + fr;
        pq[0] = SS[r]; pq[1] = SS[r + 128];
    }
    __device__ __forceinline__ void operator()(const f32x4 (&acc)[2][2][4][2], const pg8::Unit& u, int wr, int wc, int fr, int fq) const {
        const int row0 = u.pm * 256 + wr * 64 + fr, col0 = u.pn * 256 + wc * 32 + 8 * fq;
        float rsv[2][4];
#pragma unroll
        for (int ai = 0; ai < 2; ++ai) {
            const float own = ss_rstd(cq[ai]);
#pragma unroll
            for (int m = 0; m < 4; ++m) rsv[ai][m] = __shfl(own, fr + 16 * m, 64);
        }
#pragma unroll
        for (int ai = 0; ai < 2; ++ai)
#pragma unroll
            for (int m = 0; m < 4; ++m) {
                const int row = row0 + ai * 128 + m * 16;
                const float rs = rsv[ai][m];
                bf16_t* rowp = O + (size_t)row * ldc + col0;
#pragma unroll
                for (int bj = 0; bj < 2; ++bj) {
                    const f32x4 v0 = acc[ai][bj][m][0] * rs, v1 = acc[ai][bj][m][1] * rs;
                    u32x4 o; o[0] = pk2(v0[0], v0[1]); o[1] = pk2(v0[2], v0[3]); o[2] = pk2(v1[0], v1[1]); o[3] = pk2(v1[2], v1[3]);
                    *(u32x4*)(rowp + bj * 128) = o;
                }
            }
    }
};
struct EpiRes {
    static constexpr bool PERM = true, AFTER_DRAIN = false;
    bf16_t* X; u64* SS;
    __device__ __forceinline__ void pre(const pg8::Unit&, int, int, int, int) const {}
    __device__ __forceinline__ void commit() const {}
    __device__ __forceinline__ void operator()(const f32x4 (&acc)[2][2][4][2], const pg8::Unit& u, int wr, int wc, int fr, int fq) const {
        const int row0 = u.pm * 256 + wr * 64 + fr, col0 = u.pn * 256 + wc * 32 + 8 * fq;
#pragma unroll
        for (int ai = 0; ai < 2; ++ai) {
            u32x4 xall[4][2]; float ssm[4];
#pragma unroll
            for (int m = 0; m < 4; ++m)
#pragma unroll
                for (int bj = 0; bj < 2; ++bj) xall[m][bj] = *(const u32x4*)(X + (size_t)(row0 + ai * 128 + m * 16) * DM + col0 + bj * 128);
#pragma unroll
            for (int m = 0; m < 4; ++m) {
                const int row = row0 + ai * 128 + m * 16;
                bf16_t* rowp = X + (size_t)row * DM + col0;
                u32x4 xin[2];
#pragma unroll
                for (int bj = 0; bj < 2; ++bj) xin[bj] = xall[m][bj];
                float ss = 0.f;
#pragma unroll
                for (int bj = 0; bj < 2; ++bj) {
                    const f32x4 v0 = acc[ai][bj][m][0], v1 = acc[ai][bj][m][1];
                    u32x4 o;
                    o[0] = pk2(bflo(xin[bj][0]) + v0[0], bfhi(xin[bj][0]) + v0[1]); o[1] = pk2(bflo(xin[bj][1]) + v0[2], bfhi(xin[bj][1]) + v0[3]);
                    o[2] = pk2(bflo(xin[bj][2]) + v1[0], bfhi(xin[bj][2]) + v1[1]); o[3] = pk2(bflo(xin[bj][3]) + v1[2], bfhi(xin[bj][3]) + v1[3]);
#pragma unroll
                    for (int e = 0; e < 4; ++e) { const float a = bflo(o[e]), b = bfhi(o[e]); ss += a * a + b * b; }
                    *(u32x4*)(rowp + bj * 128) = o;
                }
                ss += __shfl_xor(ss, 16, 64); ss += __shfl_xor(ss, 32, 64);
                ssm[m] = ss;
            }
            {
                const float mine = fq == 0 ? ssm[0] : (fq == 1 ? ssm[1] : (fq == 2 ? ssm[2] : ssm[3]));
                atomicAdd(SS + row0 + ai * 128 + fq * 16, ss_fix(mine));
            }
        }
    }
};

__device__ __forceinline__ float dpp_ror1(float v) { return __builtin_bit_cast(float, __builtin_amdgcn_mov_dpp(__builtin_bit_cast(int, v), 0x121, 0xF, 0xF, false)); }
__device__ __forceinline__ float dpp_ror15(float v) { return __builtin_bit_cast(float, __builtin_amdgcn_mov_dpp(__builtin_bit_cast(int, v), 0x12F, 0xF, 0xF, false)); }
__device__ __forceinline__ void conv4(const float (&v)[4], float w0, float w1, float w2, float b, int fr, bool r1prev, float (&o)[4]) {
    float P[4], N[4];
#pragma unroll
    for (int m = 0; m < 4; ++m) { P[m] = dpp_ror1(v[m]); N[m] = dpp_ror15(v[m]); }
#pragma unroll
    for (int m = 0; m < 4; ++m) {
        const float prev = fr > 0 ? P[m] : (m > 0 ? P[m - 1] : 0.f), next = fr < 15 ? N[m] : (m < 3 ? N[m + 1] : 0.f);
        o[m] = w0 * prev + w1 * v[m] + w2 * next + b;
    }
}
typedef _Float16 h2 __attribute__((ext_vector_type(2)));
__device__ __forceinline__ h2 pkh(float a, float b) { return __builtin_bit_cast(h2, __builtin_amdgcn_cvt_pkrtz(a, b)); }
__device__ __forceinline__ h2 dpp_h2(h2 v, const int ctrl_is_ror15) {
    const int i = __builtin_bit_cast(int, v);
    return __builtin_bit_cast(h2, ctrl_is_ror15 ? __builtin_amdgcn_mov_dpp(i, 0x12F, 0xF, 0xF, false) : __builtin_amdgcn_mov_dpp(i, 0x121, 0xF, 0xF, false));
}
__device__ __forceinline__ h2 sel_h2(bool c, h2 a, h2 b) { const int ia = __builtin_bit_cast(int, a), ib = __builtin_bit_cast(int, b); return __builtin_bit_cast(h2, c ? ia : ib); }
__device__ __forceinline__ void conv4h(const h2 (&v)[4], h2 w0, h2 w1, h2 w2, h2 b, int fr, h2 (&o)[4]) {
    h2 P[4], N[4];
#pragma unroll
    for (int m = 0; m < 4; ++m) { P[m] = dpp_h2(v[m], 0); N[m] = dpp_h2(v[m], 1); }
    const h2 z = {(_Float16)0.f, (_Float16)0.f};
#pragma unroll
    for (int m = 0; m < 4; ++m) {
        const h2 prev = sel_h2(fr > 0, P[m], m > 0 ? P[m - 1] : z), next = sel_h2(fr < 15, N[m], m < 3 ? N[m + 1] : z);
        o[m] = w0 * prev + w1 * v[m] + w2 * next + b;
    }
}
struct EpiConv {
    static constexpr bool PERM = true, AFTER_DRAIN = false;
    bf16_t* ACT; bf16_t* HB; const u64* SS; const float* CT;
    LAS float* CTW;
    mutable u64 cq[2]; mutable f32x4 cct;
    __device__ __forceinline__ void commit() const { cq[0] = pq[0]; cq[1] = pq[1]; cct = pct; }
    mutable u64 pq[2]; mutable f32x4 pct;
    __device__ __forceinline__ void pre(const pg8::Unit& u, int wr, int wc, int fr, int fq) const {
        const int r = u.pm * 256 + wr * 64 + fq * 16 + fr;
        pq[0] = SS[r]; pq[1] = SS[r + 128];
        pct = *(const f32x4*)(CT + (size_t)(u.pn * 128 + wc * 32) * 8 + (fq * 16 + fr) * 4);
    }
    __device__ __forceinline__ void operator()(const f32x4 (&acc)[2][2][4][2], const pg8::Unit& u, int wr, int wc, int fr, int fq) const {
        asm volatile("" : "+v"(fr), "+v"(fq), "+s"(wr), "+s"(wc));
        const int row0 = u.pm * 256 + wr * 64 + fr, ch0 = u.pn * 128 + wc * 32 + 8 * fq;
        const bool r1prev = __builtin_amdgcn_mov_dpp(fr, 0x121, 0xF, 0xF, false) == ((fr + 15) & 15);
        LAS float* ctw = CTW + (wr * 4 + wc) * 256;
        *(LAS f32x4*)(ctw + (fq * 16 + fr) * 4) = cct;
        float rsa[2][4];
#pragma unroll
        for (int ai = 0; ai < 2; ++ai) {
            const float own = ss_rstd(cq[ai]);
#pragma unroll
            for (int m = 0; m < 4; ++m) rsa[ai][m] = __shfl(own, fr + 16 * m, 64);
        }
#pragma unroll
        for (int ai = 0; ai < 2; ++ai) {
            __builtin_amdgcn_sched_barrier(0);
            float rs[4];
#pragma unroll
            for (int m = 0; m < 4; ++m) rs[m] = rsa[ai][m];
            const int blk = u.pm * 4 + ai * 2 + wr;
#pragma unroll
            for (int n = 0; n < 2; ++n) {
                __builtin_amdgcn_sched_barrier(0);
                const int ch = ch0 + 4 * n;
                const LAS float* ct = ctw + (8 * fq + 4 * n) * 8;
                unsigned pk0[4];
#pragma unroll
                for (int ep = 0; ep < 2; ++ep) {
                    const int e = ep * 2;
                    const f32x4 wga = *(const LAS f32x4*)(ct + e * 8), wua = *(const LAS f32x4*)(ct + e * 8 + 4), wgb = *(const LAS f32x4*)(ct + e * 8 + 8), wub = *(const LAS f32x4*)(ct + e * 8 + 12);
                    h2 x[4], og[4], ou[4];
#pragma unroll
                    for (int m = 0; m < 4; ++m) x[m] = pkh(acc[ai][0][m][n][e] * rs[m], acc[ai][0][m][n][e + 1] * rs[m]);
                    conv4h(x, pkh(wga[0], wgb[0]), pkh(wga[1], wgb[1]), pkh(wga[2], wgb[2]), pkh(wga[3], wgb[3]), fr, og);
                    __builtin_amdgcn_sched_barrier(0);
#pragma unroll
                    for (int m = 0; m < 4; ++m) x[m] = pkh(acc[ai][1][m][n][e] * rs[m], acc[ai][1][m][n][e + 1] * rs[m]);
                    conv4h(x, pkh(wua[0], wub[0]), pkh(wua[1], wub[1]), pkh(wua[2], wub[2]), pkh(wua[3], wub[3]), fr, ou);
#pragma unroll
                    for (int m = 0; m < 4; ++m) {
                        const float g0 = (float)og[m][0], g1 = (float)og[m][1];
                        const float a0 = g0 * __builtin_amdgcn_rcpf(1.0f + __expf(-g0)) * (float)ou[m][0], a1 = g1 * __builtin_amdgcn_rcpf(1.0f + __expf(-g1)) * (float)ou[m][1];
                        const bool deferred = (m == 0 && fr == 0) || (m == 3 && fr == 15);
                        if (ep == 0) pk0[m] = pk2(a0, a1);
                        else if (!deferred) { u32x2 o; o[0] = pk0[m]; o[1] = pk2(a0, a1); *(u32x2*)(ACT + (size_t)(row0 + ai * 128 + m * 16) * DFF + ch) = o; }
                    }
                    __builtin_amdgcn_sched_barrier(0);
                }
                if (fr < 2) {
                    bf16_t* hp = HB + (size_t)(blk * 4 + fr) * NFF + ch;
                    const f32x4 a = acc[ai][0][0][n] * rs[0], b = acc[ai][1][0][n] * rs[0];
                    u32x2 o; o[0] = pk2(a[0], a[1]); o[1] = pk2(a[2], a[3]); *(u32x2*)hp = o;
                    o[0] = pk2(b[0], b[1]); o[1] = pk2(b[2], b[3]); *(u32x2*)(hp + DFF) = o;
                }
                if (fr >= 14) {
                    bf16_t* hp = HB + (size_t)(blk * 4 + fr - 12) * NFF + ch;
                    const f32x4 a = acc[ai][0][3][n] * rs[3], b = acc[ai][1][3][n] * rs[3];
                    u32x2 o; o[0] = pk2(a[0], a[1]); o[1] = pk2(a[2], a[3]); *(u32x2*)hp = o;
                    o[0] = pk2(b[0], b[1]); o[1] = pk2(b[2], b[3]); *(u32x2*)(hp + DFF) = o;
                }
            }
        }
    }
};

__device__ __forceinline__ void transpose_convert(LAS unsigned char* lds, const float* src, bf16_t* dst, int K, int N, int tile0, int tstride, const float* kscale) {
    LAS float* T = (LAS float*)lds;
    const int tid = mk_tid();
    const int ntn = N / 64, ntk = K / 64, ntiles = ntn * ntk;
    for (int t = tile0; t < ntiles; t += tstride) {
        const int tk = t / ntn, tn = t % ntn;
        {
            const int r = tid >> 3, c = (tid & 7) * 8;
            const float* s = src + (size_t)(tk * 64 + r) * N + tn * 64 + c;
            f32x4 a = *(const f32x4*)s, b = *(const f32x4*)(s + 4);
            if (kscale) { const float ks = kscale[tk * 64 + r]; a = a * ks; b = b * ks; }
            LAS float* d = T + r * 65 + c;
            d[0] = a[0]; d[1] = a[1]; d[2] = a[2]; d[3] = a[3]; d[4] = b[0]; d[5] = b[1]; d[6] = b[2]; d[7] = b[3];
        }
        lds_barrier();
        {
            const int n = tid >> 3, k0 = (tid & 7) * 8;
            float v[8];
#pragma unroll
            for (int j = 0; j < 8; ++j) v[j] = T[(k0 + j) * 65 + n];
            u32x4 o; o[0] = pk2(v[0], v[1]); o[1] = pk2(v[2], v[3]); o[2] = pk2(v[4], v[5]); o[3] = pk2(v[6], v[7]);
            *(u32x4*)(dst + (size_t)(tn * 64 + n) * K + tk * 64 + k0) = o;
        }
        lds_barrier();
    }
}

__device__ __forceinline__ void prepass_rows(const float* src, bf16_t* xb, u64* SS, int rows) {
    const int lane = mk_tid() & 63, wave = mk_tid() >> 6;
    for (int row = mk_bid() * 8 + wave; row < rows; row += gridDim.x * 8) {
        const float* s = src + (size_t)row * DM;
        f32x4 v[4];
#pragma unroll
        for (int i = 0; i < 4; ++i) v[i] = *(const f32x4*)(s + lane * 4 + i * 256);
        float ss = 0.f;
#pragma unroll
        for (int i = 0; i < 4; ++i) {
            u32x2 o; o[0] = pk2(v[i][0], v[i][1]); o[1] = pk2(v[i][2], v[i][3]);
            const float a = bflo(o[0]), b = bfhi(o[0]), c = bflo(o[1]), d = bfhi(o[1]);
            ss += a * a + b * b + c * c + d * d;
            *(u32x2*)(xb + (size_t)row * DM + lane * 4 + i * 256) = o;
        }
        ss = wave_sum(ss);
        if (lane == 0) SS[row] = ss_fix(ss);
    }
}
__device__ __forceinline__ void final_rows(const bf16_t* xb, const u64* SS, const float* gam, float* out, int rows) {
    const int lane = mk_tid() & 63, wave = mk_tid() >> 6;
    f32x4 gv[4];
#pragma unroll
    for (int i = 0; i < 4; ++i) gv[i] = *(const f32x4*)(gam + lane * 4 + i * 256);
    for (int row = mk_bid() * 8 + wave; row < rows; row += gridDim.x * 8) {
        const float rstd = ss_rstd(SS[row]);
        u32x2 w[4];
#pragma unroll
        for (int i = 0; i < 4; ++i) w[i] = *(const u32x2*)(xb + (size_t)row * DM + lane * 4 + i * 256);
#pragma unroll
        for (int i = 0; i < 4; ++i) {
            f32x4 y; y[0] = bflo(w[i][0]); y[1] = bfhi(w[i][0]); y[2] = bflo(w[i][1]); y[3] = bfhi(w[i][1]);
            y = y * rstd * gv[i];
            *(f32x4*)(out + (size_t)row * DM + lane * 4 + i * 256) = y;
        }
    }
}

__device__ __forceinline__ bf16x8 lds_frag(const LAS bf16_t* base, int row, int ld, int k) { return *(const LAS bf16x8*)(base + row * ld + k); }

constexpr int NAT_LD = 136, T64_LD = 72;
__device__ __forceinline__ float frcp(float x) { return __builtin_amdgcn_rcpf(x); }
struct Tile2 { u32x4 a, b; };
__device__ __forceinline__ Tile2 ld_tile(const bf16_t* g, int tid) {
    const int r = tid >> 3, c = (tid & 7) * 16; Tile2 t;
    t.a = *(const u32x4*)(g + (size_t)r * NCOL + c); t.b = *(const u32x4*)(g + (size_t)r * NCOL + c + 8); return t;
}
__device__ __forceinline__ void st_tile(LAS bf16_t* NAT, const Tile2& t, int tid) {
    const int r = tid >> 3, c = (tid & 7) * 16;
    *(LAS u32x4*)(NAT + r * NAT_LD + c) = t.a; *(LAS u32x4*)(NAT + r * NAT_LD + c + 8) = t.b;
}
__device__ __forceinline__ float fexp2(float x) { return __builtin_amdgcn_exp2f(x); }
__device__ __forceinline__ void gate16(const LAS bf16_t* NAT, int c, int seg, float lb, int dir, float (&b)[16], float (&kk)[16], float& tot) {
    float lf[16];
    const float olb = 1.0f - lb;
#pragma unroll
    for (int j = 0; j < 16; ++j) {
        const float z = bf2f(NAT[(seg * 16 + j) * NAT_LD + c]);
        const float e = fexp2(-1.44269504f * fabsf(z)), s = frcp(1.0f + e), es = e * s;
        const float sig = z >= 0.f ? s : es, nsig = z >= 0.f ? es : s;
        lf[j] = __builtin_amdgcn_logf(lb + olb * sig);
        kk[j] = olb * nsig;
    }
    if (dir == 0) { float a = 0.f;
#pragma unroll
        for (int j = 0; j < 16; ++j) { a += lf[j]; b[j] = a; } tot = a; }
    else { float a = 0.f;
#pragma unroll
        for (int j = 15; j >= 0; --j) { a += lf[j]; b[j] = a; } tot = a; }
}
__device__ __forceinline__ float lb_value(const Params& p, int l, int dir, int ch) {
    if (l == 0) return 0.f;
    const float l0 = p.lb_logits[(dir * 2 + 0) * 512 + ch], l1 = p.lb_logits[(dir * 2 + 1) * 512 + ch];
    return 1.0f / (1.0f + __expf(l0 - l1));
}
__device__ __forceinline__ void build_vt(const LAS bf16_t* NAT, LAS bf16_t* VT, int c, int seg) {
    unsigned w[8];
#pragma unroll
    for (int j = 0; j < 8; ++j) w[j] = (unsigned)NAT[(seg * 16 + 2 * j) * NAT_LD + c] | ((unsigned)NAT[(seg * 16 + 2 * j + 1) * NAT_LD + c] << 16);
    u32x4 a, b; a[0] = w[0]; a[1] = w[1]; a[2] = w[2]; a[3] = w[3]; b[0] = w[4]; b[1] = w[5]; b[2] = w[6]; b[3] = w[7];
    *(LAS u32x4*)(VT + c * T64_LD + seg * 16) = a; *(LAS u32x4*)(VT + c * T64_LD + seg * 16 + 8) = b;
}

constexpr int A_NV = 0, A_NZ0 = 17408, A_NZ1 = 34816, A_VT = 52224, A_KT0 = 70656, A_KT1 = 89088, A_TOT = 107520;
static_assert(A_TOT + 4096 <= 131072, "lds");
__device__ void hgrn_states(LAS unsigned char* lds, const Params& p, int l, const bf16_t* proj, bf16_t* US, float* Dd, const int NI) {
    LAS bf16_t* NV = (LAS bf16_t*)(lds + A_NV); LAS bf16_t* VT = (LAS bf16_t*)(lds + A_VT);
    LAS float* TOT = (LAS float*)(lds + A_TOT);
    const int tid = mk_tid(), lane = tid & 63, wave = tid >> 6, c = tid & 127, seg = tid >> 7;
    const int G = gridDim.x;
    int item = mk_bid();
    Tile2 tv, tz0, tz1;
    if (item < NI) { const bf16_t* base = proj + (size_t)(item >> 2) * 64 * NCOL + (item & 3) * 128; tv = ld_tile(base + C_I, tid); tz0 = ld_tile(base + C_FF, tid); tz1 = ld_tile(base + C_FB, tid); }
    int hcur = -1; float lbv[2] = {0.f, 0.f};
    for (; item < NI; item += G) {
        const int h = item & 3;
        if (h != hcur) { hcur = h; lbv[0] = lb_value(p, l, 0, h * 128 + c); lbv[1] = lb_value(p, l, 1, h * 128 + c); }
        st_tile(NV, tv, tid); st_tile((LAS bf16_t*)(lds + A_NZ0), tz0, tid); st_tile((LAS bf16_t*)(lds + A_NZ1), tz1, tid);
        { const int ni = item + G; if (ni < NI) { const bf16_t* base = proj + (size_t)(ni >> 2) * 64 * NCOL + (ni & 3) * 128; tv = ld_tile(base + C_I, tid); tz0 = ld_tile(base + C_FF, tid); tz1 = ld_tile(base + C_FB, tid); } }
        lds_barrier();
        build_vt(NV, VT, c, seg);
        float b[2][16], kk[2][16];
#pragma unroll
        for (int dir = 0; dir < 2; ++dir) {
            float tot; gate16((const LAS bf16_t*)(lds + (dir ? A_NZ1 : A_NZ0)), c, seg, lbv[dir], dir, b[dir], kk[dir], tot);
            TOT[(dir * 4 + seg) * 128 + c] = tot;
        }
        lds_barrier();
#pragma unroll
        for (int dir = 0; dir < 2; ++dir) {
            float off = 0.f, total = 0.f;
#pragma unroll
            for (int s = 0; s < 4; ++s) { const float t = TOT[(dir * 4 + s) * 128 + c]; total += t; if (dir == 0 ? (s < seg) : (s > seg)) off += t; }
            unsigned w[8];
#pragma unroll
            for (int j = 0; j < 8; ++j) {
                const float k0 = kk[dir][2 * j] * fexp2(total - (b[dir][2 * j] + off)), k1 = kk[dir][2 * j + 1] * fexp2(total - (b[dir][2 * j + 1] + off));
                w[j] = pk2(k0, k1);
            }
            u32x4 a, bb; a[0] = w[0]; a[1] = w[1]; a[2] = w[2]; a[3] = w[3]; bb[0] = w[4]; bb[1] = w[5]; bb[2] = w[6]; bb[3] = w[7];
            LAS bf16_t* KT = (LAS bf16_t*)(lds + (dir ? A_KT1 : A_KT0));
            *(LAS u32x4*)(KT + c * T64_LD + seg * 16) = a; *(LAS u32x4*)(KT + c * T64_LD + seg * 16 + 8) = bb;
            if (seg == 0) Dd[(size_t)(item * 2 + dir) * 128 + c] = fexp2(total);
        }
        lds_barrier();
        const int mb = wave & 3, nh = wave >> 2, lr = lane & 31, lh = lane >> 5;
#pragma unroll
        for (int dir = 0; dir < 2; ++dir) {
            const LAS bf16_t* KT = (const LAS bf16_t*)(lds + (dir ? A_KT1 : A_KT0));
            f32x16 acc0 = {}, acc1 = {};
#pragma unroll
            for (int ks = 0; ks < 4; ++ks) {
                const bf16x8 af = lds_frag(KT, mb * 32 + lr, T64_LD, ks * 16 + lh * 8);
                const bf16x8 b0 = lds_frag(VT, nh * 64 + lr, T64_LD, ks * 16 + lh * 8);
                const bf16x8 b1 = lds_frag(VT, nh * 64 + 32 + lr, T64_LD, ks * 16 + lh * 8);
                acc0 = __builtin_amdgcn_mfma_f32_32x32x16_bf16(af, b0, acc0, 0, 0, 0);
                acc1 = __builtin_amdgcn_mfma_f32_32x32x16_bf16(af, b1, acc1, 0, 0, 0);
            }
            bf16_t* Ub = US + (size_t)(item * 2 + dir) * 16384;
#pragma unroll
            for (int i = 0; i < 4; ++i) {
                const int k = mb * 32 + 8 * i + 4 * lh;
                u32x2 o0, o1; o0[0] = pk2(acc0[4 * i], acc0[4 * i + 1]); o0[1] = pk2(acc0[4 * i + 2], acc0[4 * i + 3]);
                o1[0] = pk2(acc1[4 * i], acc1[4 * i + 1]); o1[1] = pk2(acc1[4 * i + 2], acc1[4 * i + 3]);
                *(u32x2*)(Ub + (size_t)(nh * 64 + lr) * 128 + k) = o0;
                *(u32x2*)(Ub + (size_t)(nh * 64 + 32 + lr) * 128 + k) = o1;
            }
        }
    }
    lds_barrier();
}

__device__ void hgrn_scan(int pr, bf16_t* US, const float* Dd) {
    const int NC = pr == 0 ? 64 : 256, NSEQ = pr == 0 ? 8 : 2;
    const int nitems = NSEQ * 8 * 8192;
    for (int item = mk_bid() * NTHR + mk_tid(); item < nitems; item += gridDim.x * NTHR) {
        const int e2 = item & 8191, sq = item >> 13, dir = sq & 1, h = (sq >> 1) & 3, s = sq >> 3;
        const int k = (e2 * 2) & 127;
        float s0 = 0.f, s1 = 0.f;
        const int n0 = dir == 0 ? 0 : NC - 1, dn = dir == 0 ? 1 : -1;
        for (int nb = 0; nb < NC; nb += 32) {
            unsigned u[32]; float d0[32], d1[32];
#pragma unroll
            for (int j = 0; j < 32; ++j) {
                const int n = n0 + dn * (nb + j);
                const size_t sidx = ((size_t)(s * NC + n) * 4 + h) * 2 + dir;
                u[j] = *(const unsigned*)(US + sidx * 16384 + e2 * 2);
                const float2 dd = *(const float2*)(Dd + sidx * 128 + k);
                d0[j] = dd.x; d1[j] = dd.y;
            }
#pragma unroll
            for (int j = 0; j < 32; ++j) {
                const int n = n0 + dn * (nb + j);
                const size_t sidx = ((size_t)(s * NC + n) * 4 + h) * 2 + dir;
                *(unsigned*)(US + sidx * 16384 + e2 * 2) = pk2(s0, s1);
                s0 = d0[j] * s0 + bflo(u[j]); s1 = d1[j] * s1 + bfhi(u[j]);
            }
        }
    }
}

constexpr int C_NQ = 0, C_NV = 17408, C_NZ0 = 34816, C_NZ1 = 52224, C_VT = 69632, C_PS = 88064, C_TOT = 97280;
constexpr int C_QS = C_NQ, C_KS = C_NV, C_QI = C_NZ0, C_OL = 0;
static_assert(C_TOT + 4096 <= 131072, "lds");
__device__ __forceinline__ unsigned pair_sel(int odd) {
    const bool F = __builtin_amdgcn_perm(0x03020100u, 0x13121110u, 0x03020100u) == 0x03020100u;
    const unsigned o0 = F ? 0u : 4u, x0 = F ? 4u : 0u;
    const unsigned s_even = (o0 + 0) | ((o0 + 1) << 8) | ((x0 + 0) << 16) | ((x0 + 1) << 24);
    const unsigned s_odd = (x0 + 2) | ((x0 + 3) << 8) | ((o0 + 2) << 16) | ((o0 + 3) << 24);
    return odd ? s_odd : s_even;
}
__device__ __forceinline__ unsigned pair_word(unsigned own, unsigned sel) {
    const unsigned other = (unsigned)__builtin_amdgcn_mov_dpp((int)own, 0xB1, 0xF, 0xF, false);
    return __builtin_amdgcn_perm(own, other, sel);
}
__device__ void hgrn_out(LAS unsigned char* lds, const Params& p, int l, const bf16_t* proj, const bf16_t* US, bf16_t* mix, const int NI) {
    LAS bf16_t* VT = (LAS bf16_t*)(lds + C_VT); LAS float* TOT = (LAS float*)(lds + C_TOT);
    LAS bf16_t* QS = (LAS bf16_t*)(lds + C_QS); LAS bf16_t* KS = (LAS bf16_t*)(lds + C_KS); LAS bf16_t* QI = (LAS bf16_t*)(lds + C_QI);
    LAS bf16_t* PS = (LAS bf16_t*)(lds + C_PS); LAS float* OL = (LAS float*)(lds + C_OL);
    const int tid = mk_tid(), lane = tid & 63, wave = tid >> 6, c = tid & 127, seg = tid >> 7;
    const int G = gridDim.x;
    const int tb = wave & 1, vb = wave >> 1, lr = lane & 31, lh = lane >> 5;
    const unsigned psel = pair_sel(c & 1);
    int item = mk_bid();
    Tile2 tq, tv, tz0, tz1, tg;
    if (item < NI) { const bf16_t* base = proj + (size_t)(item >> 2) * 64 * NCOL + (item & 3) * 128;
        tq = ld_tile(base + C_Q, tid); tv = ld_tile(base + C_I, tid); tz0 = ld_tile(base + C_FF, tid); tz1 = ld_tile(base + C_FB, tid); tg = ld_tile(base + C_G, tid); }
    int hcur = -1; float lbv[2] = {0.f, 0.f}; f32x4 gnv[4];
    for (; item < NI; item += G) {
        const int cg_ = item >> 2, h = item & 3;
        if (h != hcur) {
            hcur = h; lbv[0] = lb_value(p, l, 0, h * 128 + c); lbv[1] = lb_value(p, l, 1, h * 128 + c);
            const float* gnp = p.hg_norm_g + l * 512 + h * 128 + (tid & 7) * 16;
#pragma unroll
            for (int q4 = 0; q4 < 4; ++q4) gnv[q4] = *(const f32x4*)(gnp + q4 * 4);
        }
        st_tile((LAS bf16_t*)(lds + C_NQ), tq, tid); st_tile((LAS bf16_t*)(lds + C_NV), tv, tid);
        st_tile((LAS bf16_t*)(lds + C_NZ0), tz0, tid); st_tile((LAS bf16_t*)(lds + C_NZ1), tz1, tid);
        const Tile2 gcur = tg;
        { const int ni = item + G; if (ni < NI) { const bf16_t* base = proj + (size_t)(ni >> 2) * 64 * NCOL + (ni & 3) * 128;
            tq = ld_tile(base + C_Q, tid); tv = ld_tile(base + C_I, tid); tz0 = ld_tile(base + C_FF, tid); tz1 = ld_tile(base + C_FB, tid); tg = ld_tile(base + C_G, tid); } }
        lds_barrier();
        build_vt((const LAS bf16_t*)(lds + C_NV), VT, c, seg);
        float qv[16];
#pragma unroll
        for (int j = 0; j < 16; ++j) qv[j] = bf2f(((const LAS bf16_t*)(lds + C_NQ))[(seg * 16 + j) * NAT_LD + c]);
        float bb2[2][16], kk2[2][16];
#pragma unroll
        for (int dir = 0; dir < 2; ++dir) {
            float tot; gate16((const LAS bf16_t*)(lds + (dir ? C_NZ1 : C_NZ0)), c, seg, lbv[dir], dir, bb2[dir], kk2[dir], tot);
            TOT[(dir * 4 + seg) * 128 + c] = tot;
        }
        lds_barrier();
        f32x16 oacc = {};
#pragma unroll
        for (int dir = 0; dir < 2; ++dir) {
            const bf16_t* Sg = US + (size_t)(item * 2 + dir) * 16384 + (size_t)(vb * 32 + lr) * 128 + lh * 8;
            bf16x8 sf[8];
#pragma unroll
            for (int ks = 0; ks < 8; ++ks) sf[ks] = *(const bf16x8*)(Sg + ks * 16);
            float off, ref;
            { const float t0 = TOT[(dir * 4 + 0) * 128 + c], t1 = TOT[(dir * 4 + 1) * 128 + c], t2 = TOT[(dir * 4 + 2) * 128 + c], t3 = TOT[(dir * 4 + 3) * 128 + c];
              if (dir == 0) { off = (seg > 0 ? t0 : 0.f) + (seg > 1 ? t1 : 0.f) + (seg > 2 ? t2 : 0.f); ref = t0 + t1; }
              else { off = (seg < 3 ? t3 : 0.f) + (seg < 2 ? t2 : 0.f) + (seg < 1 ? t1 : 0.f); ref = t2 + t3; } }
            if (dir == 1) lds_barrier();
#pragma unroll
            for (int j = 0; j < 16; j += 2) {
                const float b0 = bb2[dir][j] + off, b1 = bb2[dir][j + 1] + off;
                const int wofs = (seg * 16 + j + (c & 1)) * NAT_LD + (c & ~1);
                const unsigned wq = pk2(qv[j] * fexp2(b0 - ref), qv[j + 1] * fexp2(b1 - ref));
                const unsigned wk = pk2(kk2[dir][j] * fexp2(ref - b0), kk2[dir][j + 1] * fexp2(ref - b1));
                const unsigned wi = pk2(qv[j] * fexp2(b0), qv[j + 1] * fexp2(b1));
                *(LAS unsigned*)(QS + wofs) = pair_word(wq, psel);
                *(LAS unsigned*)(KS + wofs) = pair_word(wk, psel);
                *(LAS unsigned*)(QI + wofs) = pair_word(wi, psel);
            }
            lds_barrier();
            {
                const int tm = wave & 3, tn0 = (wave >> 2) * 2, r16 = lane & 15, q4 = lane >> 4;
                f32x4 s0 = {}, s1 = {};
#pragma unroll
                for (int ks = 0; ks < 4; ++ks) {
                    const bf16x8 af = lds_frag(QS, tm * 16 + r16, NAT_LD, ks * 32 + q4 * 8);
                    const bf16x8 b0 = lds_frag(KS, tn0 * 16 + r16, NAT_LD, ks * 32 + q4 * 8);
                    const bf16x8 b1 = lds_frag(KS, tn0 * 16 + 16 + r16, NAT_LD, ks * 32 + q4 * 8);
                    s0 = __builtin_amdgcn_mfma_f32_16x16x32_bf16(af, b0, s0, 0, 0, 0);
                    s1 = __builtin_amdgcn_mfma_f32_16x16x32_bf16(af, b1, s1, 0, 0, 0);
                }
#pragma unroll
                for (int r = 0; r < 4; ++r) {
                    const int t = tm * 16 + q4 * 4 + r, sa = tn0 * 16 + r16, sb = sa + 16;
                    const bool ka = dir == 0 ? (sa <= t) : (sa >= t), kb = dir == 0 ? (sb <= t) : (sb >= t);
                    PS[t * T64_LD + sa] = (bf16_t)(pk2(ka ? s0[r] : 0.f, 0.f) & 0xffffu);
                    PS[t * T64_LD + sb] = (bf16_t)(pk2(kb ? s1[r] : 0.f, 0.f) & 0xffffu);
                }
            }
            lds_barrier();
#pragma unroll
            for (int ks = 0; ks < 4; ++ks) {
                const bf16x8 af = lds_frag(PS, tb * 32 + lr, T64_LD, ks * 16 + lh * 8);
                const bf16x8 bfm = lds_frag(VT, vb * 32 + lr, T64_LD, ks * 16 + lh * 8);
                oacc = __builtin_amdgcn_mfma_f32_32x32x16_bf16(af, bfm, oacc, 0, 0, 0);
            }
#pragma unroll
            for (int ks = 0; ks < 8; ++ks) {
                const bf16x8 af = lds_frag(QI, tb * 32 + lr, NAT_LD, ks * 16 + lh * 8);
                oacc = __builtin_amdgcn_mfma_f32_32x32x16_bf16(af, sf[ks], oacc, 0, 0, 0);
            }
        }
        lds_barrier();
#pragma unroll
        for (int i = 0; i < 4; ++i)
#pragma unroll
            for (int j = 0; j < 4; ++j) OL[(tb * 32 + 8 * i + 4 * lh + j) * 132 + vb * 32 + lr] = oacc[4 * i + j];
        lds_barrier();
        {
            const int t = tid >> 3, v0 = (tid & 7) * 16;
            float ov[16]; float ss = 0.f;
#pragma unroll
            for (int j = 0; j < 16; ++j) { ov[j] = OL[t * 132 + v0 + j]; ss += ov[j] * ov[j]; }
            ss += __shfl_xor(ss, 1, 64); ss += __shfl_xor(ss, 2, 64); ss += __shfl_xor(ss, 4, 64);
            const float rstd = rsqrtf(ss * (1.0f / 128.f) + EPS);
            unsigned w[8];
#pragma unroll
            for (int j = 0; j < 8; ++j) {
                const unsigned gw = j < 4 ? gcur.a[j] : gcur.b[j - 4];
                const float g0 = bflo(gw), g1 = bfhi(gw);
                const float y0 = ov[2 * j] * rstd * gnv[j >> 1][(2 * j) & 3] * g0 * frcp(1.0f + __expf(-g0)), y1 = ov[2 * j + 1] * rstd * gnv[j >> 1][(2 * j + 1) & 3] * g1 * frcp(1.0f + __expf(-g1));
                w[j] = pk2(y0, y1);
            }
            u32x4 a, bb; a[0] = w[0]; a[1] = w[1]; a[2] = w[2]; a[3] = w[3]; bb[0] = w[4]; bb[1] = w[5]; bb[2] = w[6]; bb[3] = w[7];
            bf16_t* mp = mix + (size_t)(cg_ * 64 + t) * DM + h * 128 + v0;
            *(u32x4*)mp = a; *(u32x4*)(mp + 8) = bb;
        }
        lds_barrier();
    }
}

constexpr int L_WS = 0, L_VT2 = 34816, L_GB = 69632;
__device__ void sg_items(LAS unsigned char* lds, const Params& p, int l, const bf16_t* proj, bf16_t* mix, const int NI) {
    LAS bf16_t* WS = (LAS bf16_t*)(lds + L_WS); LAS bf16_t* VT2 = (LAS bf16_t*)(lds + L_VT2); LAS float* GB = (LAS float*)(lds + L_GB);
    const int tid = mk_tid(), lane = tid & 63, wave = tid >> 6;
    const int G = gridDim.x;
    int item = mk_bid();
    const bool hconst = (G & 3) == 0;
    int hcur = -1; float bsv[2] = {0.f, 0.f};
    for (; item < NI; item += G) {
        const int ck = item >> 2, h = item & 3;
        const int pos = tid >> 2, q0 = (tid & 3) * 32;
        const bf16_t* vp = proj + (size_t)(ck * 128 + pos) * NCOL + C_V + h * 128 + q0;
        u32x4 vr[4];
#pragma unroll
        for (int q = 0; q < 4; ++q) vr[q] = *(const u32x4*)(vp + q * 8);
        if (!hconst || hcur != h) {
            if (hcur >= 0) lds_barrier();
            hcur = h;
            bsv[0] = p.sg_b[(l * 4 + h) * 128 + (wave >> 2) * 64 + (lane & 31)]; bsv[1] = p.sg_b[(l * 4 + h) * 128 + (wave >> 2) * 64 + 32 + (lane & 31)];
            const int r = tid >> 2, c0 = (tid & 3) * 32;
            const float* s = p.sg_w + ((size_t)(l * 4 + h) * 128 + r) * 128 + c0;
            f32x4 wv[8];
#pragma unroll
            for (int q = 0; q < 8; ++q) wv[q] = *(const f32x4*)(s + q * 4);
#pragma unroll
            for (int q = 0; q < 4; ++q) {
                u32x4 o; o[0] = pk2(wv[2 * q][0], wv[2 * q][1]); o[1] = pk2(wv[2 * q][2], wv[2 * q][3]); o[2] = pk2(wv[2 * q + 1][0], wv[2 * q + 1][1]); o[3] = pk2(wv[2 * q + 1][2], wv[2 * q + 1][3]);
                *(LAS u32x4*)(WS + r * NAT_LD + c0 + q * 8) = o;
            }
            if (tid < 128) GB[tid] = p.sg_norm_g[l * 512 + h * 128 + tid]; else if (tid < 256) GB[tid] = p.sg_norm_b[l * 512 + h * 128 + tid - 128];
            lds_barrier();
        }
        {
            float x[32]; float sum = 0.f;
#pragma unroll
            for (int q = 0; q < 4; ++q)
#pragma unroll
                for (int j = 0; j < 4; ++j) { x[q * 8 + 2 * j] = gelu_t(bflo(vr[q][j])); x[q * 8 + 2 * j + 1] = gelu_t(bfhi(vr[q][j])); }
#pragma unroll
            for (int j = 0; j < 32; ++j) sum += x[j];
            sum += __shfl_xor(sum, 1, 64); sum += __shfl_xor(sum, 2, 64);
            const float mu = sum * (1.0f / 128.f);
            float var = 0.f;
#pragma unroll
            for (int j = 0; j < 32; ++j) { x[j] -= mu; var += x[j] * x[j]; }
            var += __shfl_xor(var, 1, 64); var += __shfl_xor(var, 2, 64);
            const float rstd = rsqrtf(var * (1.0f / 128.f) + EPS);
#pragma unroll
            for (int j = 0; j < 32; ++j) {
                const float y = x[j] * rstd * GB[q0 + j] + GB[128 + q0 + j];
                VT2[(q0 + j) * NAT_LD + pos] = (bf16_t)(pk2(y, 0.f) & 0xffffu);
            }
        }
        const int mb = wave & 3, nh = wave >> 2, lr = lane & 31, lh = lane >> 5;
        u32x2 uw[2][4];
#pragma unroll
        for (int nt = 0; nt < 2; ++nt)
#pragma unroll
            for (int i = 0; i < 4; ++i) uw[nt][i] = *(const u32x2*)(proj + (size_t)(ck * 128 + nh * 64 + nt * 32 + lr) * NCOL + C_U + h * 128 + mb * 32 + 8 * i + 4 * lh);
        lds_barrier();
        f32x16 acc0 = {}, acc1 = {};
#pragma unroll
        for (int ks = 0; ks < 8; ++ks) {
            const bf16x8 af = lds_frag(VT2, mb * 32 + lr, NAT_LD, ks * 16 + lh * 8);
            const bf16x8 b0 = lds_frag(WS, nh * 64 + lr, NAT_LD, ks * 16 + lh * 8);
            const bf16x8 b1 = lds_frag(WS, nh * 64 + 32 + lr, NAT_LD, ks * 16 + lh * 8);
            acc0 = __builtin_amdgcn_mfma_f32_32x32x16_bf16(af, b0, acc0, 0, 0, 0);
            acc1 = __builtin_amdgcn_mfma_f32_32x32x16_bf16(af, b1, acc1, 0, 0, 0);
        }
#pragma unroll
        for (int nt = 0; nt < 2; ++nt) {
            const int pp = nh * 64 + nt * 32 + lr;
            const float bs = bsv[nt];
            bf16_t* mp = mix + (size_t)(ck * 128 + pp) * DM + 512 + h * 128;
#pragma unroll
            for (int i = 0; i < 4; ++i) {
                const int d = mb * 32 + 8 * i + 4 * lh;
                const float a0 = (nt ? acc1[4 * i] : acc0[4 * i]) + bs, a1 = (nt ? acc1[4 * i + 1] : acc0[4 * i + 1]) + bs;
                const float a2 = (nt ? acc1[4 * i + 2] : acc0[4 * i + 2]) + bs, a3 = (nt ? acc1[4 * i + 3] : acc0[4 * i + 3]) + bs;
                u32x2 o; o[0] = pk2(gelu_t(bflo(uw[nt][i][0])) * a0, gelu_t(bfhi(uw[nt][i][0])) * a1); o[1] = pk2(gelu_t(bflo(uw[nt][i][1])) * a2, gelu_t(bfhi(uw[nt][i][1])) * a3);
                *(u32x2*)(mp + d) = o;
            }
        }
        lds_barrier();
    }
}

__device__ void conv_fixup(const Params& p, int l, int pr, const bf16_t* HB, bf16_t* act) {
    const int SL = pr == 0 ? 4096 : 16384;
    constexpr int CG = DFF / 8;
    const int nitems = CG * 512 * 2;
    const float* cw = p.conv_w + (size_t)l * 3 * NFF; const float* cb = p.conv_b + (size_t)l * NFF;
    const u32x4 zero = {0u, 0u, 0u, 0u};
    for (int item = mk_bid() * NTHR + mk_tid(); item < nitems; item += gridDim.x * NTHR) {
        const int cgp = item % CG, rest = item / CG, which = rest & 1, blk = rest >> 1, c0 = cgp * 8;
        const int t = blk * 64 + (which ? 63 : 0);
        u32x4 rows[2][3];
#pragma unroll
        for (int s = 0; s < 2; ++s) {
            const bf16_t* hb = HB + s * DFF + c0;
            if (which == 0) {
                rows[s][0] = (t % SL == 0) ? zero : *(const u32x4*)(hb + (size_t)((blk - 1) * 4 + 3) * NFF);
                rows[s][1] = *(const u32x4*)(hb + (size_t)(blk * 4 + 0) * NFF);
                rows[s][2] = *(const u32x4*)(hb + (size_t)(blk * 4 + 1) * NFF);
            } else {
                rows[s][0] = *(const u32x4*)(hb + (size_t)(blk * 4 + 2) * NFF);
                rows[s][1] = *(const u32x4*)(hb + (size_t)(blk * 4 + 3) * NFF);
                rows[s][2] = ((t + 1) % SL == 0) ? zero : *(const u32x4*)(hb + (size_t)((blk + 1) * 4 + 0) * NFF);
            }
        }
        float r[2][8];
#pragma unroll
        for (int s = 0; s < 2; ++s) {
            f32x4 w[3][2], bb[2];
#pragma unroll
            for (int k = 0; k < 3; ++k) { w[k][0] = *(const f32x4*)(cw + k * NFF + s * DFF + c0); w[k][1] = *(const f32x4*)(cw + k * NFF + s * DFF + c0 + 4); }
            bb[0] = *(const f32x4*)(cb + s * DFF + c0); bb[1] = *(const f32x4*)(cb + s * DFF + c0 + 4);
#pragma unroll
            for (int j = 0; j < 4; ++j) {
                r[s][2 * j] = w[0][j >> 1][(2 * j) & 3] * bflo(rows[s][0][j]) + w[1][j >> 1][(2 * j) & 3] * bflo(rows[s][1][j]) + w[2][j >> 1][(2 * j) & 3] * bflo(rows[s][2][j]) + bb[j >> 1][(2 * j) & 3];
                r[s][2 * j + 1] = w[0][j >> 1][(2 * j + 1) & 3] * bfhi(rows[s][0][j]) + w[1][j >> 1][(2 * j + 1) & 3] * bfhi(rows[s][1][j]) + w[2][j >> 1][(2 * j + 1) & 3] * bfhi(rows[s][2][j]) + bb[j >> 1][(2 * j + 1) & 3];
            }
        }
        u32x4 o;
#pragma unroll
        for (int j = 0; j < 4; ++j) o[j] = pk2(r[0][2 * j] * frcp(1.0f + __expf(-r[0][2 * j])) * r[1][2 * j], r[0][2 * j + 1] * frcp(1.0f + __expf(-r[0][2 * j + 1])) * r[1][2 * j + 1]);
        *(u32x4*)(act + (size_t)t * DFF + c0) = o;
    }
}

constexpr int NPHASE = 34;
__device__ __forceinline__ bool phase_empty(int) { return false; }
__device__ __forceinline__ void zero_u64(u64* p, int n) { for (int i = mk_bid() * NTHR + mk_tid(); i < n; i += gridDim.x * NTHR) p[i] = 0ull; }

__device__ __forceinline__ void run_phase(LAS unsigned char* lds, const Params& p, int ph) {
    unsigned char* ws = p.ws;
    if (ph == 0) {
        for (int l = 0; l < DEPTH; ++l) {
            transpose_convert(lds, p.w_in + (size_t)l * DM * NCOL, (bf16_t*)(ws + WS_WIN + l * SZ_WIN), DM, NCOL, mk_bid(), gridDim.x, p.norm1_g + l * DM);
            transpose_convert(lds, p.w_out + (size_t)l * DM * DM, (bf16_t*)(ws + WS_WOUT + l * SZ_WOUT), DM, DM, mk_bid(), gridDim.x, nullptr);
            transpose_convert(lds, p.w_ffn_in + (size_t)l * DM * NFF, (bf16_t*)(ws + WS_WFI + l * SZ_WFI), DM, NFF, mk_bid(), gridDim.x, p.norm2_g + l * DM);
            transpose_convert(lds, p.w_ffn_out + (size_t)l * DFF * DM, (bf16_t*)(ws + WS_WFO + l * SZ_WFO), DFF, DM, mk_bid(), gridDim.x, nullptr);
        }
        for (int i = mk_bid() * NTHR + mk_tid(); i < DEPTH * DFF * 8; i += gridDim.x * NTHR) {
            const int j = i & 7, c = (i >> 3) % DFF, l = i / (8 * DFF), s2 = j >> 2, k = j & 3;
            ((float*)(ws + WS_CT))[i] = k < 3 ? p.conv_w[((size_t)l * 3 + k) * NFF + s2 * DFF + c] : p.conv_b[(size_t)l * NFF + s2 * DFF + c];
        }
        prepass_rows(p.x_prompt, (bf16_t*)(ws + WS_XB), (u64*)(ws + WS_SS1), 2 * GT);
        prepass_rows(p.x_sample, (bf16_t*)(ws + WS_XB) + (size_t)2 * GT * DM, (u64*)(ws + WS_SS1) + 2 * GT, 2 * GT);
        return;
    }
    if (ph == NPHASE - 1) { final_rows((const bf16_t*)(ws + WS_XB), (const u64*)(ws + WS_SS1), p.final_g, p.out, NGROUP * GT); return; }
    const int q = ph - 1, k = q & 7, pl = q >> 3, l = pl & 1, pr = pl >> 1;
    bf16_t* XBP = (bf16_t*)(ws + WS_XB) + (size_t)pr * PT * DM;
    u64* SS1 = (u64*)(ws + WS_SS1) + (size_t)pr * PT; u64* SS2 = (u64*)(ws + WS_SS2);
    bf16_t* PROJ = (bf16_t*)(ws + WS_PROJ); bf16_t* US = (bf16_t*)((unsigned char*)p.out + OUT_US); float* Dd = (float*)((unsigned char*)p.out + OUT_D);
    bf16_t* MIX = (bf16_t*)(ws + WS_MIX); bf16_t* ACT = (bf16_t*)(ws + WS_ACT);
    switch (k) {
    case 0: {
        pg8::Gemm gm; gm.A = XBP; gm.M = PT; gm.K = DM; gm.Bt = (const bf16_t*)(ws + WS_WIN + l * SZ_WIN); gm.N = NCOL;
        pg8::StaticOrder S; S.init(PT, NCOL, gridDim.x, mk_bid());
        EpiB16 E; E.O = PROJ; E.ldc = NCOL; E.SS = SS1;
        pg8::gemm_phase<EpiB16, pg8::StaticOrder, false>(lds, gm, S, E, nullptr);
    } break;
    case 1: zero_u64(SS2, PT);
            hgrn_states(lds, p, l, PROJ, US, Dd, 2048); sg_items(lds, p, l, PROJ, MIX, 1024); break;
    case 2: zero_u64(SS1, PT);
            hgrn_scan(pr, US, Dd); break;
    case 3: hgrn_out(lds, p, l, PROJ, US, MIX, 2048); break;
    case 4: {
        pg8::Gemm gm; gm.M = PT; gm.N = DM; gm.A = MIX; gm.Bt = (const bf16_t*)(ws + WS_WOUT + l * SZ_WOUT); gm.K = DM;
        pg8::StaticOrder S; S.init(PT, DM, gridDim.x, mk_bid());
        EpiRes E; E.X = XBP; E.SS = SS2;
        pg8::gemm_phase<EpiRes, pg8::StaticOrder, false>(lds, gm, S, E, nullptr);
    } break;
    case 5: {
        pg8::Gemm gm; gm.A = XBP; gm.M = PT; gm.K = DM; gm.Bt = (const bf16_t*)(ws + WS_WFI + l * SZ_WFI); gm.N = NFF;
        gm.bh = (size_t)DFF * DM * 2; gm.bt = (size_t)128 * DM * 2;
        pg8::StaticOrder S; S.init(PT, NFF, gridDim.x, mk_bid());
        EpiConv E; E.ACT = ACT; E.HB = (bf16_t*)(ws + WS_HB); E.SS = SS2; E.CT = (const float*)(ws + WS_CT) + (size_t)l * DFF * 8; E.CTW = (LAS float*)(lds + LDS_CTW_OFF);
        pg8::gemm_phase<EpiConv, pg8::StaticOrder, false>(lds, gm, S, E, nullptr);
    } break;
    case 6: conv_fixup(p, l, pr, (const bf16_t*)(ws + WS_HB), ACT); break;
    case 7: {
        pg8::Gemm gm; gm.M = PT; gm.N = DM; gm.A = ACT; gm.Bt = (const bf16_t*)(ws + WS_WFO + l * SZ_WFO); gm.K = DFF;
        pg8::StaticOrder S; S.init(PT, DM, gridDim.x, mk_bid());
        EpiRes E; E.X = XBP; E.SS = SS1;
        pg8::gemm_phase<EpiRes, pg8::StaticOrder, false>(lds, gm, S, E, nullptr);
    } break;
    }
}

#ifdef DBG_STOP
__device__ void dbg_phase(const Params& p, int ph) {
    float* acc = (float*)(p.ws + WS_END);
    const int tid = mk_tid(), bid = mk_bid();
    if (ph == 100) { if (bid == 0 && tid < 2) acc[tid] = 0.f; return; }
    if (ph == 101) {
        const size_t n = (size_t)DBG_N; float ss = 0.f, nf = 0.f;
        for (size_t i = (size_t)bid * NTHR + tid; i < n; i += (size_t)gridDim.x * NTHR) {
#if DBG_F32
            const float v = DBG_F32 == 2 ? p.out[i] : ((const float*)(p.ws + DBG_OFF))[i];
#else
            const float v = bf2f(((const bf16_t*)(p.ws + DBG_OFF))[i]);
#endif
            if (fabsf(v) < 1e30f) ss += v * v; else nf += 1.f;
        }
        ss = wave_sum(ss); nf = wave_sum(nf);
        if ((tid & 63) == 0) { atomicAdd(acc, ss); atomicAdd(acc + 1, nf); }
        return;
    }
    if (ph == 102) {
        const float stat = (DBG_KIND == 0 ? acc[0] : acc[1]) / (float)DBG_N;
        const float c = sqrtf((stat + 1e-6f) * 1e6f);
        for (size_t i = (size_t)bid * NTHR + tid; i < (size_t)NGROUP * GT * DM; i += (size_t)gridDim.x * NTHR) p.out[i] = c;
    }
}
#endif
__global__ void __launch_bounds__(NTHR, 2) mega(Params p) {
    extern __shared__ __attribute__((aligned(16))) unsigned char smem[];
    LAS unsigned char* lds = (LAS unsigned char*)smem;
    cg::grid_group grid = cg::this_grid();
#if ONE_LAUNCH
    volatile LAS unsigned* st = (volatile LAS unsigned*)(lds + LDS_BAR_OFF);
    if (mk_tid() < 4) st[mk_tid()] = 0u;
    __syncthreads();
    XcdBarrier bar = xcd_barrier_post((unsigned*)(p.ws + WS_BAR), st);
#endif
#ifdef DBG_TIME
    unsigned long long* TS = (unsigned long long*)(p.ws + WS_TS);
    if (mk_bid() == 0 && mk_tid() == 0) TS[0] = __builtin_amdgcn_s_memrealtime();
#endif
    for (int ph = p.ph_lo; ph < p.ph_hi; ++ph) {
#ifdef DBG_STOP
        if (ph >= 100) { dbg_phase(p, ph); continue; }
#endif
        if (phase_empty(ph)) continue;
        run_phase(lds, p, ph);
#if ONE_LAUNCH
        if (ph + 1 < p.ph_hi) { if (p.ph_lo < 0) grid.sync(); else xcd_barrier(bar); }
#endif
#ifdef DBG_TIME
        if (mk_bid() == 0 && mk_tid() == 0) TS[ph + 1] = __builtin_amdgcn_s_memrealtime();
#endif
    }
#ifdef DBG_TIME
    xcd_barrier(bar);
    {
        float s1 = 0.f, s2 = 0.f;
        for (int ph = 0; ph < NPHASE; ++ph) {
            const int kind = ph == 0 ? 0 : (ph == NPHASE - 1 ? 9 : 1 + ((ph - 1) & 7));
            const float d = (float)(TS[ph + 1] - TS[ph]);
            if (kind == DBG_K1) s1 += d; if (kind == DBG_K2) s2 += d;
        }
        s1 = exp2f(0.5f * rintf(2.0f * log2f(fmaxf(s1, 1.f)))); s2 = exp2f(0.5f * rintf(2.0f * log2f(fmaxf(s2, 1.f))));
        const float c = sqrtf(s1);
        for (size_t i = (size_t)mk_bid() * NTHR + mk_tid(); i < (size_t)NGROUP * GT * DM; i += (size_t)gridDim.x * NTHR) p.out[i] = (i == 0) ? s2 : c;
    }
#endif
}

#ifndef ONE_LAUNCH
#define ONE_LAUNCH 0
#endif

extern "C" void kernel_launch(void* const* d_in, const int* in_sizes, int n_in, void* d_out, int out_size, void* d_ws, size_t ws_size, hipStream_t stream) {
    static int grid = 0;
    if (grid == 0) {
        int dev = 0, cus = 0, per_cu = 0;
        hipGetDevice(&dev);
        hipDeviceGetAttribute(&cus, hipDeviceAttributeMultiprocessorCount, dev);
        if (hipFuncSetAttribute((const void*)mega, hipFuncAttributeMaxDynamicSharedMemorySize, LDS_BYTES) != hipSuccess) { fprintf(stderr, "hipFuncSetAttribute failed\n"); grid = -1; return; }
        if (hipOccupancyMaxActiveBlocksPerMultiprocessor(&per_cu, (const void*)mega, NTHR, LDS_BYTES) != hipSuccess || per_cu < 1) { fprintf(stderr, "occupancy query: %d\n", per_cu); per_cu = 1; }
        (void)hipGetLastError();
        grid = cus * 1;
        if (ws_size < WS_END) { fprintf(stderr, "workspace too small: %zu < %zu\n", ws_size, (size_t)WS_END); grid = -1; return; }
    }
    if (grid < 0) return;
    Params p{};
    p.x_prompt = (const float*)d_in[0]; p.x_sample = (const float*)d_in[1]; p.norm1_g = (const float*)d_in[2]; p.w_in = (const float*)d_in[3];
    p.lb_logits = (const float*)d_in[4]; p.hg_norm_g = (const float*)d_in[5]; p.sg_norm_g = (const float*)d_in[6]; p.sg_norm_b = (const float*)d_in[7];
    p.sg_w = (const float*)d_in[8]; p.sg_b = (const float*)d_in[9]; p.w_out = (const float*)d_in[10]; p.norm2_g = (const float*)d_in[11];
    p.w_ffn_in = (const float*)d_in[12]; p.conv_w = (const float*)d_in[13]; p.conv_b = (const float*)d_in[14]; p.w_ffn_out = (const float*)d_in[15];
    p.final_g = (const float*)d_in[16]; p.out = (float*)d_out; p.ws = (unsigned char*)d_ws;
#if ONE_LAUNCH
    (void)hipMemsetAsync((char*)d_ws + WS_BAR, 0, 16384, stream);
    p.ph_lo = 0; p.ph_hi = NPHASE;
    void* args[] = {&p};
    hipError_t e = hipLaunchCooperativeKernel((const void*)mega, dim3(grid), dim3(NTHR), args, LDS_BYTES, stream);
    if (e != hipSuccess) fprintf(stderr, "cooperative launch failed: %s (grid %d)\n", hipGetErrorString(e), grid);
#else
#ifdef DBG_STOP
    for (int ph = 0; ph <= 102; ++ph) {
        if (ph > DBG_STOP && ph < 100) continue;
        p.ph_lo = ph; p.ph_hi = ph + 1;
#else
    for (int ph = 0; ph < NPHASE; ++ph) {
        p.ph_lo = ph; p.ph_hi = ph + 1;
#endif
        hipLaunchKernelGGL(mega, dim3(grid), dim3(NTHR), LDS_BYTES, stream, p);
    }
#endif
}
```
